# Optimizing an MI355X kernel written in HIP

```python
import math
import jax, jax.numpy as jnp
from jax import lax
import numpy as np

D_MODEL = 1024
BATCH = 4
SEQ = 4096
DEPTH = 1

PLE_DIM = 256
DN_HEADS = 8
DN_DK = 128
DN_DV = 128
DN_CONV = 4
DN_CHUNK = 64
DN_QK_W = DN_HEADS * DN_DK
DN_V_W = DN_HEADS * DN_DV
DN_CONV_CH = 2 * DN_QK_W + DN_V_W
MLA_HEADS = 8
MLA_Q_LORA = 384
MLA_KV_LORA = 256
MLA_NOPE = 128
MLA_ROPE = 64
MLA_V = 128
MLA_V_W = MLA_HEADS * MLA_V
ROPE_BASE = 10000.0
Q_BLOCK = 128
FFN_HIDDEN = -(-8 * D_MODEL // (3 * 256)) * 256
DEEPNORM_ALPHA = (2.0 * DEPTH) ** 0.25
DEEPNORM_BETA = (8.0 * DEPTH) ** -0.25
IN_SIZES = (DN_CONV_CH, DN_V_W, DN_HEADS, DN_HEADS, MLA_Q_LORA, MLA_KV_LORA, MLA_ROPE, D_MODEL, D_MODEL)
D_IN = sum(IN_SIZES)
SPLIT_IDX = tuple(int(v) for v in np.cumsum(IN_SIZES)[:-1])
NEG_BIG = -1e30

kernel_name = 'hybrid_deltanet_mla_deepnorm_block'


def layer_norm(t, g, b, eps=1e-5):
    tf = t.astype(jnp.float32)
    mu = jnp.mean(tf, axis=-1, keepdims=True)
    var = jnp.mean(jnp.square(tf - mu), axis=-1, keepdims=True)
    return ((tf - mu) * lax.rsqrt(var + eps) * g.astype(jnp.float32) + b.astype(jnp.float32)).astype(t.dtype)


def rms_norm(t, w, eps=1e-6):
    tf = t.astype(jnp.float32)
    return tf * lax.rsqrt(jnp.mean(jnp.square(tf), axis=-1, keepdims=True) + eps) * w.astype(jnp.float32)


def l2_normalize(t, eps=1e-6):
    tf = t.astype(jnp.float32)
    return tf * lax.rsqrt(jnp.sum(jnp.square(tf), axis=-1, keepdims=True) + eps)


def rope_tables(positions):
    inv_freq = ROPE_BASE ** (-jnp.arange(0, MLA_ROPE, 2, dtype=jnp.float32) / MLA_ROPE)
    ang = positions.astype(jnp.float32)[..., None] * inv_freq
    return jnp.cos(ang), jnp.sin(ang)


def apply_rope(t, cos, sin):
    t1, t2 = jnp.split(t.astype(jnp.float32), 2, axis=-1)
    return jnp.concatenate([t1 * cos - t2 * sin, t2 * cos + t1 * sin], axis=-1)


def causal_depthwise_conv(t, w):
    width, ch = w.shape
    return lax.conv_general_dilated(t, w[:, None, :].astype(t.dtype), window_strides=(1,), padding=[(width - 1, 0)], dimension_numbers=('NWC', 'WIO', 'NWC'), feature_group_count=ch)


def gated_delta_rule(q, k, v, beta, g):
    b, s, h, dk = q.shape
    dv = v.shape[-1]
    c = DN_CHUNK
    n = s // c

    def chunk(t):
        return jnp.swapaxes(t.reshape((b, n, c) + t.shape[2:]), 2, 3)

    q, k, v, beta, g = (chunk(t) for t in (q, k, v, beta, g))
    g = jnp.cumsum(g, axis=-1)
    tril = jnp.tril(jnp.ones((c, c), dtype=bool))
    strict = jnp.tril(jnp.ones((c, c), dtype=bool), k=-1)
    diff = g[..., :, None] - g[..., None, :]
    decay = jnp.where(tril, jnp.exp(jnp.where(tril, diff, 0.0)), 0.0)
    k_beta = k * beta[..., None]
    l_mat = jnp.where(strict, jnp.einsum('bnhid,bnhjd->bnhij', k_beta, k) * decay, 0.0)
    eye = jnp.eye(c, dtype=q.dtype)
    t_inv = lax.linalg.triangular_solve(eye + l_mat, jnp.broadcast_to(eye, l_mat.shape), left_side=True, lower=True, unit_diagonal=True)
    u = jnp.einsum('bnhij,bnhje->bnhie', t_inv, v * beta[..., None])
    w = jnp.einsum('bnhij,bnhjd->bnhid', t_inv, k_beta * jnp.exp(g)[..., None])
    intra = jnp.where(tril, jnp.einsum('bnhid,bnhjd->bnhij', q, k) * decay, 0.0)
    q_dec = q * jnp.exp(g)[..., None]
    g_last = g[..., -1]
    k_tail = k * jnp.exp(g_last[..., None] - g)[..., None]

    def step(state, xs):
        w_c, u_c, q_c, a_c, kt_c, gl_c = xs
        v_new = u_c - jnp.einsum('bhcd,bhde->bhce', w_c, state)
        o_c = jnp.einsum('bhcd,bhde->bhce', q_c, state) + jnp.einsum('bhij,bhje->bhie', a_c, v_new)
        state = state * jnp.exp(gl_c)[..., None, None] + jnp.einsum('bhcd,bhce->bhde', kt_c, v_new)
        return state, o_c

    xs = tuple(jnp.moveaxis(t, 1, 0) for t in (w, u, q_dec, intra, k_tail, g_last))
    state0 = jnp.zeros((b, h, dk, dv), q.dtype)
    _, o = lax.scan(step, state0, xs)
    return jnp.transpose(o, (1, 0, 3, 2, 4)).reshape(b, s, h, dv)


def mla_attention(q_lat, q_rope, c_kv, k_rope):
    b, s, h, c = q_lat.shape
    nblk = s // Q_BLOCK
    scale = (MLA_NOPE + MLA_ROPE) ** -0.5
    ckv = c_kv.astype(jnp.float32)
    kr = k_rope.astype(jnp.float32)
    key_idx = jnp.arange(s)

    def blocks(t):
        return jnp.swapaxes(t.reshape((b, nblk, Q_BLOCK) + t.shape[2:]), 0, 1)

    def one_block(args):
        ql, qr, blk = args
        sc = (jnp.einsum('bqhc,bkc->bhqk', ql, ckv) + jnp.einsum('bqhr,bkr->bhqk', qr, kr)) * scale
        q_idx = blk * Q_BLOCK + jnp.arange(Q_BLOCK)
        sc = jnp.where(key_idx[None, :] <= q_idx[:, None], sc, NEG_BIG)
        pr = jax.nn.softmax(sc, axis=-1)
        return jnp.einsum('bhqk,bkc->bqhc', pr, ckv)

    out = lax.map(one_block, (blocks(q_lat.astype(jnp.float32)), blocks(q_rope.astype(jnp.float32)), jnp.arange(nblk)))
    return jnp.swapaxes(out, 0, 1).reshape(b, s, h, c)


def setup_inputs(seed: int = 0) -> dict:
    key = jax.random.key(seed)
    ks = jax.random.split(key, 32)

    def nrm(k, shape, scale):
        return jax.random.normal(k, shape, jnp.float32) * scale

    x = nrm(ks[0], (BATCH, SEQ, D_MODEL), 1.0)
    p = nrm(ks[1], (DEPTH, BATCH, SEQ, PLE_DIM), 1.0)
    positions = jax.random.randint(ks[2], (BATCH, 1), 0, 1024, dtype=jnp.int32) + jnp.arange(SEQ, dtype=jnp.int32)[None, :]
    w_in = nrm(ks[3], (DEPTH, D_MODEL, D_IN), D_MODEL ** -0.5)
    conv_w = nrm(ks[4], (DEPTH, DN_CONV, DN_CONV_CH), DN_CONV ** -0.5)
    dn_a_log = jnp.log(jax.random.uniform(ks[5], (DEPTH, DN_HEADS), jnp.float32, 1.0, 16.0))
    dt = jnp.exp(jax.random.uniform(ks[6], (DEPTH, DN_HEADS), jnp.float32, math.log(1e-3), math.log(1e-1)))
    dn_dt_bias = dt + jnp.log(-jnp.expm1(-dt))
    dn_norm_w = 1.0 + nrm(ks[7], (DEPTH, DN_DV), 0.01)
    q_norm_w = 1.0 + nrm(ks[8], (DEPTH, MLA_Q_LORA), 0.01)
    w_uq = nrm(ks[9], (DEPTH, MLA_Q_LORA, MLA_HEADS, MLA_NOPE + MLA_ROPE), MLA_Q_LORA ** -0.5)
    kv_norm_w = 1.0 + nrm(ks[10], (DEPTH, MLA_KV_LORA), 0.01)
    w_uk = nrm(ks[11], (DEPTH, MLA_KV_LORA, MLA_HEADS, MLA_NOPE), MLA_KV_LORA ** -0.5)
    w_uv = nrm(ks[12], (DEPTH, MLA_KV_LORA, MLA_HEADS, MLA_V), MLA_KV_LORA ** -0.5)
    w_br_dn = nrm(ks[13], (DEPTH, DN_V_W, D_MODEL), DN_V_W ** -0.5)
    w_br_mla = nrm(ks[14], (DEPTH, MLA_V_W, D_MODEL), MLA_V_W ** -0.5)
    w_o = nrm(ks[15], (DEPTH, D_MODEL, D_MODEL), D_MODEL ** -0.5 * DEEPNORM_BETA)
    ln1_g = 1.0 + nrm(ks[16], (DEPTH, D_MODEL), 0.01)
    ln1_b = nrm(ks[17], (DEPTH, D_MODEL), 0.01)
    w_ffn_in = nrm(ks[18], (DEPTH, D_MODEL, 2 * FFN_HIDDEN), D_MODEL ** -0.5)
    w_ffn_out = nrm(ks[19], (DEPTH, FFN_HIDDEN, D_MODEL), FFN_HIDDEN ** -0.5 * DEEPNORM_BETA)
    w_ple = nrm(ks[20], (DEPTH, PLE_DIM, D_MODEL), PLE_DIM ** -0.5 * DEEPNORM_BETA)
    w_ple_gate = nrm(ks[21], (DEPTH, D_MODEL, D_MODEL), D_MODEL ** -0.5)
    ln2_g = 1.0 + nrm(ks[22], (DEPTH, D_MODEL), 0.01)
    ln2_b = nrm(ks[23], (DEPTH, D_MODEL), 0.01)
    return {'x': x, 'p': p, 'positions': positions, 'w_in': w_in, 'conv_w': conv_w, 'dn_a_log': dn_a_log, 'dn_dt_bias': dn_dt_bias, 'dn_norm_w': dn_norm_w, 'q_norm_w': q_norm_w, 'w_uq': w_uq, 'kv_norm_w': kv_norm_w, 'w_uk': w_uk, 'w_uv': w_uv, 'w_br_dn': w_br_dn, 'w_br_mla': w_br_mla, 'w_o': w_o, 'ln1_g': ln1_g, 'ln1_b': ln1_b, 'w_ffn_in': w_ffn_in, 'w_ffn_out': w_ffn_out, 'w_ple': w_ple, 'w_ple_gate': w_ple_gate, 'ln2_g': ln2_g, 'ln2_b': ln2_b}


def reference(x, p, positions, w_in, conv_w, dn_a_log, dn_dt_bias, dn_norm_w, q_norm_w, w_uq, kv_norm_w, w_uk, w_uv, w_br_dn, w_br_mla, w_o, ln1_g, ln1_b, w_ffn_in, w_ffn_out, w_ple, w_ple_gate, ln2_g, ln2_b):
    b, s, _ = x.shape
    cos, sin = rope_tables(positions)
    h = x
    for i in range(DEPTH):
        proj = h @ w_in[i]
        qkv, z, b_raw, a_raw, cq, ckv, kr, gate_dn, gate_mla = jnp.split(proj, SPLIT_IDX, axis=-1)

        qkv = jax.nn.silu(causal_depthwise_conv(qkv, conv_w[i]))
        dq, dk, dv = jnp.split(qkv, [DN_QK_W, 2 * DN_QK_W], axis=-1)
        dq = l2_normalize(dq.reshape(b, s, DN_HEADS, DN_DK)) * (DN_DK ** -0.5)
        dk = l2_normalize(dk.reshape(b, s, DN_HEADS, DN_DK))
        dv = dv.reshape(b, s, DN_HEADS, DN_DV).astype(jnp.float32)
        beta = jax.nn.sigmoid(b_raw.astype(jnp.float32))
        g = -jnp.exp(dn_a_log[i].astype(jnp.float32)) * jax.nn.softplus(a_raw.astype(jnp.float32) + dn_dt_bias[i].astype(jnp.float32))
        o_dn = gated_delta_rule(dq, dk, dv, beta, g)
        o_dn = rms_norm(o_dn, dn_norm_w[i]) * jax.nn.silu(z.reshape(b, s, DN_HEADS, DN_DV).astype(jnp.float32))
        y_dn = o_dn.reshape(b, s, DN_V_W).astype(h.dtype) @ w_br_dn[i]

        c_q = rms_norm(cq, q_norm_w[i]).astype(h.dtype)
        q_full = jnp.einsum('bsc,chd->bshd', c_q, w_uq[i])
        q_nope, q_rope = jnp.split(q_full, [MLA_NOPE], axis=-1)
        q_rope = apply_rope(q_rope, cos[:, :, None, :], sin[:, :, None, :])
        c_kv = rms_norm(ckv, kv_norm_w[i])
        k_rope = apply_rope(kr, cos, sin)
        q_lat = jnp.einsum('bshd,chd->bshc', q_nope.astype(jnp.float32), w_uk[i].astype(jnp.float32))
        out_lat = mla_attention(q_lat, q_rope, c_kv, k_rope)
        o_mla = jnp.einsum('bshc,chd->bshd', out_lat, w_uv[i].astype(jnp.float32))
        y_mla = o_mla.reshape(b, s, MLA_V_W).astype(h.dtype) @ w_br_mla[i]

        mixed = jax.nn.sigmoid(gate_dn) * y_dn + jax.nn.sigmoid(gate_mla) * y_mla
        h = layer_norm(DEEPNORM_ALPHA * h + mixed @ w_o[i], ln1_g[i], ln1_b[i])

        gt, up = jnp.split(h @ w_ffn_in[i], 2, axis=-1)
        ffn = (jax.nn.silu(gt) * up) @ w_ffn_out[i]
        ple = jax.nn.sigmoid(h @ w_ple_gate[i]) * (p[i] @ w_ple[i])
        h = layer_norm(DEEPNORM_ALPHA * h + ffn + ple, ln2_g[i], ln2_b[i])
    return h
```

```cpp
#include <hip/hip_runtime.h>
#include <hip/hip_cooperative_groups.h>
#include <cstdint>
#include <cstdio>
namespace cg = cooperative_groups;

#define DI __device__ __forceinline__
typedef unsigned short bf16_t;
typedef short bf16x8 __attribute__((ext_vector_type(8)));
typedef float f32x4 __attribute__((ext_vector_type(4)));
typedef float f32x2 __attribute__((ext_vector_type(2)));
typedef unsigned u32x4 __attribute__((ext_vector_type(4)));
typedef unsigned u32x2 __attribute__((ext_vector_type(2)));

#ifndef NLAUNCH
#define NLAUNCH 1
#endif

constexpr int Bn = 4, S = 4096, D = 1024, M = Bn * S;
constexpr int NA = 3840, NB = 3072, NIN = NA + NB;
constexpr int FF = 2816;
constexpr int NTHREADS = 512, NWAVES = 8;
constexpr int LDS_BYTES = 147456;
constexpr float ALPHA = 1.189207115002721f;
constexpr float C2 = 0.07216878364870322f * 1.4426950408889634f;

constexpr size_t MiB = 1u << 20;
constexpr size_t W_IN = 0, W_UQ = W_IN + (size_t)NIN * 1024 * 2, W_UKV = W_UQ + (size_t)1536 * 384 * 2, W_BRDN = W_UKV + (size_t)2048 * 256 * 2,
                 W_BRMLA = W_BRDN + 2 * MiB, W_O = W_BRMLA + 2 * MiB, W_FFNIN = W_O + 2 * MiB, W_FFNOUT = W_FFNIN + (size_t)5632 * 1024 * 2,
                 W_PG = W_FFNOUT + (size_t)1024 * FF * 2, W_PLE = W_PG + 2 * MiB, W_END = W_PLE + (size_t)1024 * 256 * 2;
static_assert(W_END <= 41 * MiB, "weights");
constexpr size_t O_AB = 41 * MiB, O_BETA = 42 * MiB, O_GG = 42 * MiB + MiB / 2, O_CQ = 43 * MiB, O_CKV = 55 * MiB, O_KR = 63 * MiB, O_PB = 43 * MiB;
constexpr size_t ARENA = 65 * MiB;
constexpr size_t O_PROJA = ARENA, O_DV = ARENA + 120 * MiB, O_ODN = ARENA + 152 * MiB;
constexpr size_t O_Q = ARENA, O_KN = ARENA + 48 * MiB, O_V = ARENA + 80 * MiB, O_OMLA = ARENA + 112 * MiB;
constexpr size_t O_PROJB = ARENA;
constexpr size_t O_H1 = ARENA, O_H1B = ARENA + 64 * MiB, O_ACT = ARENA + 96 * MiB;
static_assert(O_ODN + 32 * MiB <= 256 * MiB && O_ACT + 88 * MiB <= 256 * MiB, "ws map");

struct Params {
    const float* x; const float* p; const int* pos; const float* w_in; const float* conv_w; const float* a_log; const float* dt_bias; const float* dn_norm_w;
    const float* q_norm_w; const float* w_uq; const float* kv_norm_w; const float* w_uk; const float* w_uv; const float* w_br_dn; const float* w_br_mla; const float* w_o;
    const float* ln1_g; const float* ln1_b; const float* w_ffn_in; const float* w_ffn_out; const float* w_ple; const float* w_ple_gate; const float* ln2_g; const float* ln2_b;
    float* out; unsigned char* ws; int ph_lo, ph_hi;
};

DI unsigned f2bf(float f) { unsigned u = __float_as_uint(f); return (u + 0x7fffu + ((u >> 16) & 1u)) >> 16; }
DI unsigned pk2(float lo, float hi) { return f2bf(lo) | (f2bf(hi) << 16); }
DI float bflo(unsigned u) { return __uint_as_float(u << 16); }
DI float bfhi(unsigned u) { return __uint_as_float(u & 0xffff0000u); }
DI float bf2f(bf16_t b) { return __uint_as_float(((unsigned)b) << 16); }
DI float sigm(float x) { return 1.f / (1.f + __expf(-x)); }
DI float silu(float x) { return x / (1.f + __expf(-x)); }
DI float wave_sum(float v) {
#pragma unroll
    for (int o = 1; o < 64; o <<= 1) v += __shfl_xor(v, o);
    return v;
}
DI float wave_max(float v) {
#pragma unroll
    for (int o = 1; o < 64; o <<= 1) v = fmaxf(v, __shfl_xor(v, o));
    return v;
}
DI void st4(bf16_t* p, f32x4 v) { u32x2 w; w.x = pk2(v[0], v[1]); w.y = pk2(v[2], v[3]); *(u32x2*)p = w; }
DI f32x4 ld4(const bf16_t* p) { const u32x2 w = *(const u32x2*)p; return (f32x4){bflo(w.x), bfhi(w.x), bflo(w.y), bfhi(w.y)}; }
DI void rope_cs(int pos, int i, float& c, float& s) {
    const float inv = exp2f(-(float)i * (13.287712379549449f / 32.f));
    const float ang = (float)pos * inv;
    const double a = (double)ang; const double k = rint(a * 0.15915494309189535); const float r = (float)(a - k * 6.283185307179586);
    c = __cosf(r); s = __sinf(r);
}

DI void transpose_mat(const float* __restrict__ W, int K, int ldw, bf16_t* __restrict__ WT, int nrows, int mode, int gw, int ngw, int lane) {
    const int nkb = K / 64, nitems = (nrows / 64) * nkb;
    for (int it = gw; it < nitems; it += ngw) {
        const int nb = it / nkb, kb = it % nkb, n = nb * 64 + lane;
        int sc = n;
        if (mode == 1) { if (n < 3072) sc = n; else if (n < 3792) sc = n + 1024; else if (n < 3840) sc = -1; else { const int nn = n - 3840; sc = nn < 1024 ? nn + 3072 : nn + 3792; } }
        else if (mode == 3) { const int t = n >> 8, w = n & 255; sc = w < 128 ? 128 * t + w : 2816 + 128 * t + (w - 128); }
        else if (mode == 4) { const int h = n / 192, d = n % 192; if (d >= 128) { const int r = d - 128; sc = h * 192 + 128 + (r >> 1) + 32 * (r & 1); } }
#pragma unroll 2
        for (int c = 0; c < 8; ++c) {
            const int k0 = kb * 64 + c * 8; float v[8];
#pragma unroll
            for (int j = 0; j < 8; ++j) v[j] = sc >= 0 ? W[(size_t)(k0 + j) * ldw + sc] : 0.f;
            u32x4 o; o.x = pk2(v[0], v[1]); o.y = pk2(v[2], v[3]); o.z = pk2(v[4], v[5]); o.w = pk2(v[6], v[7]);
            *(u32x4*)(WT + (size_t)n * K + k0) = o;
        }
    }
}
DI void cvt_rows(const float* __restrict__ src, bf16_t* __restrict__ dst, size_t n8, size_t gt, size_t ngt) {
    for (size_t i = gt; i < n8; i += ngt) { const f32x4 a = *(const f32x4*)(src + i * 8), b = *(const f32x4*)(src + i * 8 + 4);
        u32x4 o; o.x = pk2(a[0], a[1]); o.y = pk2(a[2], a[3]); o.z = pk2(b[0], b[1]); o.w = pk2(b[2], b[3]); *(u32x4*)(dst + i * 8) = o; }
}

template <class Epi>
DI void gemm_simple(const bf16_t* __restrict__ A, int lda, const bf16_t* __restrict__ Bt, int ldb, int Mm, int N, int K, const Epi& E) {
    const int tid = threadIdx.x, lane = tid & 63, wid = tid >> 6, wr = wid >> 2, wc = wid & 3, fr = lane & 15, fq = lane >> 4;
    const int ntn = N / 256, ntm = Mm / 64, nt = ntn * ntm;
    for (int t = blockIdx.x; t < nt; t += gridDim.x) {
        const int tm = t / ntn, tn = t % ntn;
        const int m0 = tm * 64 + wr * 32, n0 = tn * 256 + wc * 32;
        f32x4 acc[2][4];
#pragma unroll
        for (int i = 0; i < 2; ++i)
#pragma unroll
            for (int j = 0; j < 4; ++j) acc[i][j] = (f32x4){0.f, 0.f, 0.f, 0.f};
        const bf16_t* ap = A + (size_t)(m0 + fr) * lda + fq * 8;
        const bf16_t* bp = Bt + (size_t)(n0 + fr) * ldb + fq * 8;
        for (int k = 0; k < K; k += 32) {
            bf16x8 a[2], b[4];
#pragma unroll
            for (int mi = 0; mi < 2; ++mi) a[mi] = *(const bf16x8*)(ap + (size_t)mi * 16 * lda + k);
#pragma unroll
            for (int ni = 0; ni < 4; ++ni) b[ni] = *(const bf16x8*)(bp + (size_t)((ni & 1) * 16 + (ni >> 1) * 128) * ldb + k);
#pragma unroll
            for (int mi = 0; mi < 2; ++mi)
#pragma unroll
                for (int ni = 0; ni < 4; ++ni) acc[mi][ni] = __builtin_amdgcn_mfma_f32_16x16x32_bf16(b[ni], a[mi], acc[mi][ni], 0, 0, 0);
        }
#pragma unroll
        for (int mi = 0; mi < 2; ++mi)
#pragma unroll
            for (int ni = 0; ni < 2; ++ni) E(m0 + mi * 16 + fr, n0 + ni * 16 + 4 * fq, acc[mi][ni], acc[mi][ni + 2]);
    }
}

struct EpiProjA { bf16_t* O; float* AB;
    DI void operator()(int r, int c, f32x4 a, f32x4 b) const { bf16_t* o = O + (size_t)r * NA + c; st4(o, a); st4(o + 128, b);
        if (c >= 3072 && c < 3088) *(f32x4*)(AB + (size_t)r * 16 + (c - 3072)) = a; } };
struct EpiStore { bf16_t* O; int ldo;
    DI void operator()(int r, int c, f32x4 a, f32x4 b) const { bf16_t* o = O + (size_t)r * ldo + c; st4(o, a); st4(o + 128, b); } };
struct EpiQ { bf16_t* O; const int* pos;
    DI void one(int r, int c, f32x4 v) const { const int d = c % 192;
        if (d >= 128) { const int i0 = (d - 128) >> 1; const int ps = pos[r]; float c0, s0, c1, s1; rope_cs(ps, i0, c0, s0); rope_cs(ps, i0 + 1, c1, s1);
            v = (f32x4){v[0] * c0 - v[1] * s0, v[1] * c0 + v[0] * s0, v[2] * c1 - v[3] * s1, v[3] * c1 + v[2] * s1}; }
        st4(O + (size_t)r * 1536 + c, v * C2); }
    DI void operator()(int r, int c, f32x4 a, f32x4 b) const { one(r, c, a); one(r, c + 128, b); } };
struct EpiKV { bf16_t* KN; bf16_t* V;
    DI void one(int r, int c, f32x4 v) const { if (c < 1024) st4(KN + (size_t)r * 1024 + c, v); else st4(V + (size_t)r * 1024 + c - 1024, v); }
    DI void operator()(int r, int c, f32x4 a, f32x4 b) const { one(r, c, a); one(r, c + 128, b); } };
struct EpiYdn { bf16_t* P;
    DI void one(int r, int c, f32x4 v) const { bf16_t* g = P + (size_t)r * NB + 1024 + c; const f32x4 gv = ld4(g);
        st4(g, (f32x4){sigm(gv[0]) * v[0], sigm(gv[1]) * v[1], sigm(gv[2]) * v[2], sigm(gv[3]) * v[3]}); }
    DI void operator()(int r, int c, f32x4 a, f32x4 b) const { one(r, c, a); one(r, c + 128, b); } };
struct EpiYmla { bf16_t* P;
    DI void one(int r, int c, f32x4 v) const { bf16_t* g = P + (size_t)r * NB + 2048 + c; const f32x4 gv = ld4(g), tv = ld4(g - 1024);
        st4(g, (f32x4){tv[0] + sigm(gv[0]) * v[0], tv[1] + sigm(gv[1]) * v[1], tv[2] + sigm(gv[2]) * v[2], tv[3] + sigm(gv[3]) * v[3]}); }
    DI void operator()(int r, int c, f32x4 a, f32x4 b) const { one(r, c, a); one(r, c + 128, b); } };
struct EpiWo { const float* x; float* T1;
    DI void one(int r, int c, f32x4 v) const { const size_t o = (size_t)r * D + c; *(f32x4*)(T1 + o) = *(const f32x4*)(x + o) * ALPHA + v; }
    DI void operator()(int r, int c, f32x4 a, f32x4 b) const { one(r, c, a); one(r, c + 128, b); } };
struct EpiFfnIn { bf16_t* ACT;
    DI void operator()(int r, int c, f32x4 a, f32x4 b) const { const int t = c >> 8, j = c & 255;
        st4(ACT + (size_t)r * FF + 128 * t + j, (f32x4){silu(a[0]) * b[0], silu(a[1]) * b[1], silu(a[2]) * b[2], silu(a[3]) * b[3]}); } };
struct EpiSg { bf16_t* SG;
    DI void one(int r, int c, f32x4 v) const { st4(SG + (size_t)r * D + c, (f32x4){sigm(v[0]), sigm(v[1]), sigm(v[2]), sigm(v[3])}); }
    DI void operator()(int r, int c, f32x4 a, f32x4 b) const { one(r, c, a); one(r, c + 128, b); } };
struct EpiPle { bf16_t* SG;
    DI void one(int r, int c, f32x4 v) const { bf16_t* g = SG + (size_t)r * D + c; st4(g, ld4(g) * v); }
    DI void operator()(int r, int c, f32x4 a, f32x4 b) const { one(r, c, a); one(r, c + 128, b); } };
struct EpiFfnOut { float* H1; const bf16_t* PLE;
    DI void one(int r, int c, f32x4 v) const { const size_t o = (size_t)r * D + c; *(f32x4*)(H1 + o) = *(const f32x4*)(H1 + o) * ALPHA + v + ld4(PLE + o); }
    DI void operator()(int r, int c, f32x4 a, f32x4 b) const { one(r, c, a); one(r, c + 128, b); } };

DI void p2_tokens(const Params& P, int gw, int ngw, int lane) {
    unsigned char* ws = P.ws;
    const bf16_t* PA = (const bf16_t*)(ws + O_PROJA); const float* AB = (const float*)(ws + O_AB);
    bf16_t* DQ = (bf16_t*)P.out; bf16_t* DK = DQ + (size_t)M * 1024; bf16_t* DV = (bf16_t*)(ws + O_DV);
    float* BETA = (float*)(ws + O_BETA); float* GG = (float*)(ws + O_GG);
    bf16_t* CQ = (bf16_t*)(ws + O_CQ); bf16_t* CKV = (bf16_t*)(ws + O_CKV); bf16_t* KR = (bf16_t*)(ws + O_KR);
    for (int m = gw; m < M; m += ngw) {
        const int s = m % S;
        const bf16_t* row = PA + (size_t)m * NA;
        for (int hg = 0; hg < 24; ++hg) {
            const int c = hg * 128 + 2 * lane;
            float a0 = 0.f, a1 = 0.f;
#pragma unroll
            for (int i = 0; i < 4; ++i) { if (s - 3 + i >= 0) { const unsigned u = *(const unsigned*)(row + (ptrdiff_t)(i - 3) * NA + c); const f32x2 w = *(const f32x2*)(P.conv_w + i * 3072 + c);
                a0 += w.x * bflo(u); a1 += w.y * bfhi(u); } }
            a0 = silu(a0); a1 = silu(a1);
            if (hg < 16) { const float ss = wave_sum(a0 * a0 + a1 * a1); float r = rsqrtf(ss + 1e-6f); if (hg < 8) r *= 0.08838834764831845f; a0 *= r; a1 *= r; }
            bf16_t* dst = hg < 8 ? DQ : (hg < 16 ? DK : DV);
            *(unsigned*)(dst + (size_t)m * 1024 + (hg & 7) * 128 + 2 * lane) = pk2(a0, a1);
        }
        if (lane < 8) { const float br = AB[(size_t)m * 16 + lane], ar = AB[(size_t)m * 16 + 8 + lane];
            BETA[(size_t)m * 8 + lane] = sigm(br);
            const float xx = ar + P.dt_bias[lane]; const float sp = fmaxf(xx, 0.f) + log1pf(__expf(-fabsf(xx)));
            GG[(size_t)m * 8 + lane] = -__expf(P.a_log[lane]) * sp; }
        {
            float v[6]; float ss = 0.f;
#pragma unroll
            for (int j = 0; j < 3; ++j) { const unsigned u = *(const unsigned*)(row + 3088 + 128 * j + 2 * lane); v[2 * j] = bflo(u); v[2 * j + 1] = bfhi(u); ss += v[2 * j] * v[2 * j] + v[2 * j + 1] * v[2 * j + 1]; }
            const float r = rsqrtf(wave_sum(ss) * (1.f / 384.f) + 1e-6f);
#pragma unroll
            for (int j = 0; j < 3; ++j) { const int idx = 128 * j + 2 * lane; *(unsigned*)(CQ + (size_t)m * 384 + idx) = pk2(v[2 * j] * r * P.q_norm_w[idx], v[2 * j + 1] * r * P.q_norm_w[idx + 1]); }
        }
        {
            float v[4]; float ss = 0.f;
#pragma unroll
            for (int j = 0; j < 2; ++j) { const unsigned u = *(const unsigned*)(row + 3472 + 128 * j + 2 * lane); v[2 * j] = bflo(u); v[2 * j + 1] = bfhi(u); ss += v[2 * j] * v[2 * j] + v[2 * j + 1] * v[2 * j + 1]; }
            const float r = rsqrtf(wave_sum(ss) * (1.f / 256.f) + 1e-6f);
#pragma unroll
            for (int j = 0; j < 2; ++j) { const int idx = 128 * j + 2 * lane; *(unsigned*)(CKV + (size_t)m * 256 + idx) = pk2(v[2 * j] * r * P.kv_norm_w[idx], v[2 * j + 1] * r * P.kv_norm_w[idx + 1]); }
        }
        if (lane < 32) { const float t1 = bf2f(row[3728 + lane]), t2 = bf2f(row[3728 + 32 + lane]); float c, sn; rope_cs(P.pos[m], lane, c, sn);
            *(unsigned*)(KR + (size_t)m * 64 + 2 * lane) = pk2(t1 * c - t2 * sn, t2 * c + t1 * sn); }
    }
}

DI void delta_naive(const Params& P, float* lds) {
    unsigned char* ws = P.ws;
    const bf16_t* DQ = (const bf16_t*)P.out; const bf16_t* DK = DQ + (size_t)M * 1024; const bf16_t* DV = (const bf16_t*)(ws + O_DV);
    const float* BETA = (const float*)(ws + O_BETA); const float* GG = (const float*)(ws + O_GG); bf16_t* ODN = (bf16_t*)(ws + O_ODN);
    float* kq = lds; float* red = kq + 256; float* red2 = red + 512;
    const int tid = threadIdx.x, e = tid & 127, qd = tid >> 7;
    for (int u = blockIdx.x; u < 32; u += gridDim.x) {
        const int b = u >> 3, h = u & 7;
        float st[32];
#pragma unroll
        for (int j = 0; j < 32; ++j) st[j] = 0.f;
        for (int t = 0; t < S; ++t) {
            const size_t m = (size_t)b * S + t;
            if (tid < 128) kq[tid] = bf2f(DK[m * 1024 + h * 128 + tid]); else if (tid < 256) kq[tid] = bf2f(DQ[m * 1024 + h * 128 + tid - 128]);
            const float v = bf2f(DV[m * 1024 + h * 128 + e]); const float beta = BETA[m * 8 + h], dec = __expf(GG[m * 8 + h]);
            __syncthreads();
            float part = 0.f;
#pragma unroll
            for (int j = 0; j < 32; ++j) { st[j] *= dec; part += kq[32 * qd + j] * st[j]; }
            red[qd * 128 + e] = part;
            __syncthreads();
            const float ks = red[e] + red[128 + e] + red[256 + e] + red[384 + e];
            const float vn = beta * (v - ks);
            float po = 0.f;
#pragma unroll
            for (int j = 0; j < 32; ++j) { st[j] += kq[32 * qd + j] * vn; po += kq[128 + 32 * qd + j] * st[j]; }
            red2[qd * 128 + e] = po;
            __syncthreads();
            if (qd == 0) ODN[m * 1024 + h * 128 + e] = (bf16_t)f2bf(red2[e] + red2[128 + e] + red2[256 + e] + red2[384 + e]);
        }
        __syncthreads();
    }
}

DI void attn_naive(const Params& P, float* lds, int gw, int ngw, int lane, int wid) {
    unsigned char* ws = P.ws;
    const bf16_t* Q = (const bf16_t*)(ws + O_Q); const bf16_t* KN = (const bf16_t*)(ws + O_KN); const bf16_t* V = (const bf16_t*)(ws + O_V); const bf16_t* KR = (const bf16_t*)(ws + O_KR);
    bf16_t* OM = (bf16_t*)(ws + O_OMLA);
    float* sc = lds + wid * (4096 + 192); float* qf = sc + 4096;
    for (int R = gw; R < M * 8; R += ngw) {
        const int h = R & 7, m = R >> 3, b = m / S, s = m % S;
        asm volatile("s_waitcnt lgkmcnt(0)" ::: "memory");
        const bf16_t* qrow = Q + (size_t)m * 1536 + h * 192;
        for (int d = lane; d < 192; d += 64) qf[d] = bf2f(qrow[d]);
        asm volatile("s_waitcnt lgkmcnt(0)" ::: "memory");
        float mx = -1e30f;
        for (int j = lane; j <= s; j += 64) {
            const size_t mk = (size_t)b * S + j;
            const bf16_t* kn = KN + mk * 1024 + h * 128; const bf16_t* kr = KR + mk * 64;
            float acc = 0.f;
            for (int c = 0; c < 24; ++c) { const u32x4 u = c < 16 ? *(const u32x4*)(kn + 8 * c) : *(const u32x4*)(kr + 8 * (c - 16)); const float* q8 = qf + 8 * c;
                acc += bflo(u.x) * q8[0] + bfhi(u.x) * q8[1] + bflo(u.y) * q8[2] + bfhi(u.y) * q8[3] + bflo(u.z) * q8[4] + bfhi(u.z) * q8[5] + bflo(u.w) * q8[6] + bfhi(u.w) * q8[7]; }
            sc[j] = acc; mx = fmaxf(mx, acc);
        }
        mx = wave_max(mx);
        asm volatile("s_waitcnt lgkmcnt(0)" ::: "memory");
        float l = 0.f, o0 = 0.f, o1 = 0.f;
        const bf16_t* vb = V + (size_t)b * S * 1024 + h * 128 + 2 * lane;
        for (int j = 0; j <= s; ++j) { const float pj = exp2f(sc[j] - mx); l += pj; const unsigned u = *(const unsigned*)(vb + (size_t)j * 1024); o0 += pj * bflo(u); o1 += pj * bfhi(u); }
        const float il = 1.f / l;
        *(unsigned*)(OM + (size_t)m * 1024 + h * 128 + 2 * lane) = pk2(o0 * il, o1 * il);
    }
}

DI void p9_normgate(const Params& P, int gw, int ngw, int lane) {
    unsigned char* ws = P.ws;
    const bf16_t* ODN = (const bf16_t*)(ws + O_ODN); const bf16_t* PB = (const bf16_t*)(ws + O_PROJB); bf16_t* OG = (bf16_t*)P.out + (size_t)M * 1024;
    const float w0 = P.dn_norm_w[2 * lane], w1 = P.dn_norm_w[2 * lane + 1];
    for (int m = gw; m < M; m += ngw) {
#pragma unroll
        for (int h = 0; h < 8; ++h) {
            const unsigned u = *(const unsigned*)(ODN + (size_t)m * 1024 + h * 128 + 2 * lane); const float o0 = bflo(u), o1 = bfhi(u);
            const float r = rsqrtf(wave_sum(o0 * o0 + o1 * o1) * (1.f / 128.f) + 1e-6f);
            const unsigned z = *(const unsigned*)(PB + (size_t)m * NB + h * 128 + 2 * lane);
            *(unsigned*)(OG + (size_t)m * 1024 + h * 128 + 2 * lane) = pk2(o0 * r * w0 * silu(bflo(z)), o1 * r * w1 * silu(bfhi(z)));
        }
    }
}
DI void ln_rows(const float* __restrict__ in, float* __restrict__ outf, bf16_t* __restrict__ outb, const float* g, const float* bta, int gw, int ngw, int lane) {
    for (int m = gw; m < M; m += ngw) {
        const f32x4* xr = (const f32x4*)(in + (size_t)m * D) + lane;
        f32x4 v[4]; float s = 0.f;
#pragma unroll
        for (int j = 0; j < 4; ++j) { v[j] = xr[64 * j]; s += (v[j][0] + v[j][1]) + (v[j][2] + v[j][3]); }
        const float mean = wave_sum(s) * (1.f / D); float s2 = 0.f;
#pragma unroll
        for (int j = 0; j < 4; ++j) { v[j] = v[j] - mean; s2 += (v[j][0] * v[j][0] + v[j][1] * v[j][1]) + (v[j][2] * v[j][2] + v[j][3] * v[j][3]); }
        const float rstd = rsqrtf(wave_sum(s2) * (1.f / D) + 1e-5f);
#pragma unroll
        for (int j = 0; j < 4; ++j) { const int c = 4 * lane + 256 * j; const f32x4 gg = *(const f32x4*)(g + c), bb = *(const f32x4*)(bta + c); const f32x4 o = v[j] * rstd * gg + bb;
            *(f32x4*)(outf + (size_t)m * D + c) = o; if (outb) st4(outb + (size_t)m * D + c, o); }
    }
}

constexpr int NPH = 19;
__global__ void __launch_bounds__(NTHREADS) mega(Params P) {
    extern __shared__ __attribute__((aligned(16))) unsigned char lds[];
    cg::grid_group grid = cg::this_grid();
    const int tid = threadIdx.x, lane = tid & 63, wid = tid >> 6;
    const int gw = blockIdx.x * NWAVES + wid, ngw = gridDim.x * NWAVES;
    const size_t gt = (size_t)blockIdx.x * NTHREADS + tid, ngt = (size_t)gridDim.x * NTHREADS;
    unsigned char* ws = P.ws;
    bf16_t* WIN = (bf16_t*)(ws + W_IN);
    bf16_t* XB = (bf16_t*)P.out;
    for (int ph = P.ph_lo; ph < P.ph_hi; ++ph) {
        if (ph > P.ph_lo) grid.sync();
        switch (ph) {
        case 0: {
            transpose_mat(P.w_in, 1024, 6864, WIN, NIN, 1, gw, ngw, lane);
            transpose_mat(P.w_uq, 384, 1536, (bf16_t*)(ws + W_UQ), 1536, 4, gw, ngw, lane);
            transpose_mat(P.w_uk, 256, 1024, (bf16_t*)(ws + W_UKV), 1024, 0, gw, ngw, lane);
            transpose_mat(P.w_uv, 256, 1024, (bf16_t*)(ws + W_UKV) + (size_t)1024 * 256, 1024, 0, gw, ngw, lane);
            transpose_mat(P.w_br_dn, 1024, 1024, (bf16_t*)(ws + W_BRDN), 1024, 0, gw, ngw, lane);
            transpose_mat(P.w_br_mla, 1024, 1024, (bf16_t*)(ws + W_BRMLA), 1024, 0, gw, ngw, lane);
            transpose_mat(P.w_o, 1024, 1024, (bf16_t*)(ws + W_O), 1024, 0, gw, ngw, lane);
            transpose_mat(P.w_ffn_in, 1024, 5632, (bf16_t*)(ws + W_FFNIN), 5632, 3, gw, ngw, lane);
            transpose_mat(P.w_ffn_out, FF, 1024, (bf16_t*)(ws + W_FFNOUT), 1024, 0, gw, ngw, lane);
            transpose_mat(P.w_ple_gate, 1024, 1024, (bf16_t*)(ws + W_PG), 1024, 0, gw, ngw, lane);
            transpose_mat(P.w_ple, 256, 1024, (bf16_t*)(ws + W_PLE), 1024, 0, gw, ngw, lane);
            cvt_rows(P.x, XB, (size_t)M * D / 8, gt, ngt);
        } break;
        case 1: { EpiProjA E{(bf16_t*)(ws + O_PROJA), (float*)(ws + O_AB)}; gemm_simple(XB, 1024, WIN, 1024, M, NA, 1024, E); } break;
        case 2: p2_tokens(P, gw, ngw, lane); break;
        case 3: delta_naive(P, (float*)lds); break;
        case 4: { EpiQ E{(bf16_t*)(ws + O_Q), P.pos}; gemm_simple((const bf16_t*)(ws + O_CQ), 384, (const bf16_t*)(ws + W_UQ), 384, M, 1536, 384, E); } break;
        case 5: { EpiKV E{(bf16_t*)(ws + O_KN), (bf16_t*)(ws + O_V)}; gemm_simple((const bf16_t*)(ws + O_CKV), 256, (const bf16_t*)(ws + W_UKV), 256, M, 2048, 256, E); } break;
        case 6: attn_naive(P, (float*)lds, gw, ngw, lane, wid); break;
        case 7: cvt_rows(P.x, XB, (size_t)M * D / 8, gt, ngt); break;
        case 8: { EpiStore E{(bf16_t*)(ws + O_PROJB), NB}; gemm_simple(XB, 1024, WIN + (size_t)NA * 1024, 1024, M, NB, 1024, E); } break;
        case 9: p9_normgate(P, gw, ngw, lane); break;
        case 10: { EpiYdn E{(bf16_t*)(ws + O_PROJB)}; gemm_simple((const bf16_t*)P.out + (size_t)M * 1024, 1024, (const bf16_t*)(ws + W_BRDN), 1024, M, 1024, 1024, E); } break;
        case 11: { EpiYmla E{(bf16_t*)(ws + O_PROJB)}; gemm_simple((const bf16_t*)(ws + O_OMLA), 1024, (const bf16_t*)(ws + W_BRMLA), 1024, M, 1024, 1024, E); } break;
        case 12: { EpiWo E{P.x, P.out}; gemm_simple((const bf16_t*)(ws + O_PROJB) + 2048, NB, (const bf16_t*)(ws + W_O), 1024, M, 1024, 1024, E); } break;
        case 13: { ln_rows(P.out, (float*)(ws + O_H1), (bf16_t*)(ws + O_H1B), P.ln1_g, P.ln1_b, gw, ngw, lane);
                   cvt_rows(P.p, (bf16_t*)(ws + O_PB), (size_t)M * 256 / 8, gt, ngt); } break;
        case 14: { EpiFfnIn E{(bf16_t*)(ws + O_ACT)}; gemm_simple((const bf16_t*)(ws + O_H1B), 1024, (const bf16_t*)(ws + W_FFNIN), 1024, M, 5632, 1024, E); } break;
        case 15: { EpiSg E{(bf16_t*)P.out}; gemm_simple((const bf16_t*)(ws + O_H1B), 1024, (const bf16_t*)(ws + W_PG), 1024, M, 1024, 1024, E); } break;
        case 16: { EpiPle E{(bf16_t*)P.out}; gemm_simple((const bf16_t*)(ws + O_PB), 256, (const bf16_t*)(ws + W_PLE), 256, M, 1024, 256, E); } break;
        case 17: { EpiFfnOut E{(float*)(ws + O_H1), (const bf16_t*)P.out}; gemm_simple((const bf16_t*)(ws + O_ACT), FF, (const bf16_t*)(ws + W_FFNOUT), FF, M, 1024, FF, E); } break;
        case 18: ln_rows((const float*)(ws + O_H1), P.out, nullptr, P.ln2_g, P.ln2_b, gw, ngw, lane); break;
        default: break;
        }
    }
}

extern "C" void kernel_launch(void* const* d_in, const int* in_sizes, int n_in, void* d_out, int out_size, void* d_ws, size_t ws_size, hipStream_t stream) {
    static int grid = 0;
    if (grid == 0) {
        int dev = 0, cus = 0, per_cu = 0;
        (void)hipGetDevice(&dev);
        (void)hipDeviceGetAttribute(&cus, hipDeviceAttributeMultiprocessorCount, dev);
        (void)hipFuncSetAttribute((const void*)mega, hipFuncAttributeMaxDynamicSharedMemorySize, LDS_BYTES);
        (void)hipOccupancyMaxActiveBlocksPerMultiprocessor(&per_cu, (const void*)mega, NTHREADS, LDS_BYTES);
        if (per_cu < 1) per_cu = 1;
        grid = cus * per_cu;
        if (ws_size < 256 * MiB) { fprintf(stderr, "workspace too small: %zu\n", ws_size); grid = -1; }
    }
    if (grid < 0) return;
    Params P{};
    const float** pf = (const float**)&P;
    for (int i = 0; i < 24; ++i) pf[i] = (const float*)d_in[i];
    P.out = (float*)d_out; P.ws = (unsigned char*)d_ws;
#if NLAUNCH == 1
    P.ph_lo = 0; P.ph_hi = NPH;
    { void* args[] = {&P}; hipError_t e = hipLaunchCooperativeKernel((const void*)mega, dim3(grid), dim3(NTHREADS), args, LDS_BYTES, stream);
      if (e != hipSuccess) fprintf(stderr, "cooperative launch failed: %s\n", hipGetErrorString(e)); }
#else
    for (int ph = 0; ph < NPH; ++ph) { P.ph_lo = ph; P.ph_hi = ph + 1; void* args[] = {&P};
        hipError_t e = hipLaunchCooperativeKernel((const void*)mega, dim3(grid), dim3(NTHREADS), args, LDS_BYTES, stream);
        if (e != hipSuccess) { fprintf(stderr, "cooperative launch failed: %s\n", hipGetErrorString(e)); break; } }
#endif
}
```

```cpp
#include <hip/hip_runtime.h>
#include <hip/hip_cooperative_groups.h>
#include <cstdint>
#include <cstdio>
namespace cg = cooperative_groups;

#define DI __device__ __forceinline__
typedef unsigned short bf16_t;
typedef short bf16x8 __attribute__((ext_vector_type(8)));
typedef float f32x4 __attribute__((ext_vector_type(4)));
typedef float f32x2 __attribute__((ext_vector_type(2)));
typedef unsigned u32x4 __attribute__((ext_vector_type(4)));
typedef unsigned u32x2 __attribute__((ext_vector_type(2)));

#ifndef NLAUNCH
#define NLAUNCH 1
#endif

constexpr int Bn = 4, S = 4096, D = 1024, M = Bn * S;
constexpr int NA = 3840, NB = 3072, NIN = NA + NB;
constexpr int FF = 2816;
constexpr int NTHREADS = 512, NWAVES = 8;
constexpr int LDS_BYTES = 147456;
constexpr float ALPHA = 1.189207115002721f;
constexpr float C2 = 0.07216878364870322f * 1.4426950408889634f;

constexpr size_t MiB = 1u << 20;
constexpr size_t W_IN = 0, W_UQ = W_IN + (size_t)NIN * 1024 * 2, W_UKV = W_UQ + (size_t)1536 * 384 * 2, W_BRDN = W_UKV + (size_t)2048 * 256 * 2,
                 W_BRMLA = W_BRDN + 2 * MiB, W_O = W_BRMLA + 2 * MiB, W_FFNIN = W_O + 2 * MiB, W_FFNOUT = W_FFNIN + (size_t)5632 * 1024 * 2,
                 W_PG = W_FFNOUT + (size_t)1024 * FF * 2, W_PLE = W_PG + 2 * MiB, W_END = W_PLE + (size_t)1024 * 256 * 2;
static_assert(W_END <= 41 * MiB, "weights");
constexpr size_t O_AB = 41 * MiB, O_BETA = 42 * MiB, O_GG = 42 * MiB + MiB / 2, O_CQ = 43 * MiB, O_CKV = 55 * MiB, O_KR = 63 * MiB, O_PB = 43 * MiB;
constexpr size_t ARENA = 65 * MiB;
constexpr size_t O_PROJA = ARENA, O_DV = ARENA + 120 * MiB, O_ODN = ARENA + 152 * MiB;
constexpr size_t O_Q = ARENA, O_KN = ARENA + 48 * MiB, O_V = ARENA + 80 * MiB, O_OMLA = ARENA + 112 * MiB;
constexpr size_t O_PROJB = ARENA;
constexpr size_t O_WT = ARENA, O_INTRA = ARENA + 32 * MiB, O_U = ARENA + 48 * MiB, O_KT = ARENA + 80 * MiB, O_EGL = O_AB;
constexpr size_t O_H1 = ARENA, O_H1B = ARENA + 64 * MiB, O_ACT = ARENA + 96 * MiB;
static_assert(O_ODN + 32 * MiB <= 256 * MiB && O_ACT + 88 * MiB <= 256 * MiB, "ws map");

struct Params {
    const float* x; const float* p; const int* pos; const float* w_in; const float* conv_w; const float* a_log; const float* dt_bias; const float* dn_norm_w;
    const float* q_norm_w; const float* w_uq; const float* kv_norm_w; const float* w_uk; const float* w_uv; const float* w_br_dn; const float* w_br_mla; const float* w_o;
    const float* ln1_g; const float* ln1_b; const float* w_ffn_in; const float* w_ffn_out; const float* w_ple; const float* w_ple_gate; const float* ln2_g; const float* ln2_b;
    float* out; unsigned char* ws; int ph_lo, ph_hi;
};

DI unsigned f2bf(float f) { unsigned u = __float_as_uint(f); return (u + 0x7fffu + ((u >> 16) & 1u)) >> 16; }
DI unsigned pk2(float lo, float hi) { return f2bf(lo) | (f2bf(hi) << 16); }
DI float bflo(unsigned u) { return __uint_as_float(u << 16); }
DI float bfhi(unsigned u) { return __uint_as_float(u & 0xffff0000u); }
DI float bf2f(bf16_t b) { return __uint_as_float(((unsigned)b) << 16); }
DI float sigm(float x) { return 1.f / (1.f + __expf(-x)); }
DI float silu(float x) { return x / (1.f + __expf(-x)); }
DI float wave_sum(float v) {
#pragma unroll
    for (int o = 1; o < 64; o <<= 1) v += __shfl_xor(v, o);
    return v;
}
DI float wave_max(float v) {
#pragma unroll
    for (int o = 1; o < 64; o <<= 1) v = fmaxf(v, __shfl_xor(v, o));
    return v;
}
DI void st4(bf16_t* p, f32x4 v) { u32x2 w; w.x = pk2(v[0], v[1]); w.y = pk2(v[2], v[3]); *(u32x2*)p = w; }
DI f32x4 ld4(const bf16_t* p) { const u32x2 w = *(const u32x2*)p; return (f32x4){bflo(w.x), bfhi(w.x), bflo(w.y), bfhi(w.y)}; }
DI void rope_cs(int pos, int i, float& c, float& s) {
    const float inv = exp2f(-(float)i * (13.287712379549449f / 32.f));
    const float ang = (float)pos * inv;
    const double a = (double)ang; const double k = rint(a * 0.15915494309189535); const float r = (float)(a - k * 6.283185307179586);
    c = __cosf(r); s = __sinf(r);
}

DI void transpose_mat(const float* __restrict__ W, int K, int ldw, bf16_t* __restrict__ WT, int nrows, int mode, int gw, int ngw, int lane) {
    const int nkb = K / 64, nitems = (nrows / 64) * nkb;
    for (int it = gw; it < nitems; it += ngw) {
        const int nb = it / nkb, kb = it % nkb, n = nb * 64 + lane;
        int sc = n;
        if (mode == 1) { if (n < 3072) sc = n; else if (n < 3792) sc = n + 1024; else if (n < 3840) sc = -1; else { const int nn = n - 3840; sc = nn < 1024 ? nn + 3072 : nn + 3792; } }
        else if (mode == 3) { const int t = n >> 8, w = n & 255; sc = w < 128 ? 128 * t + w : 2816 + 128 * t + (w - 128); }
        else if (mode == 4) { const int h = n / 192, d = n % 192; if (d >= 128) { const int r = d - 128; sc = h * 192 + 128 + (r >> 1) + 32 * (r & 1); } }
#pragma unroll 2
        for (int c = 0; c < 8; ++c) {
            const int k0 = kb * 64 + c * 8; float v[8];
#pragma unroll
            for (int j = 0; j < 8; ++j) v[j] = sc >= 0 ? W[(size_t)(k0 + j) * ldw + sc] : 0.f;
            u32x4 o; o.x = pk2(v[0], v[1]); o.y = pk2(v[2], v[3]); o.z = pk2(v[4], v[5]); o.w = pk2(v[6], v[7]);
            *(u32x4*)(WT + (size_t)n * K + k0) = o;
        }
    }
}
DI void cvt_rows(const float* __restrict__ src, bf16_t* __restrict__ dst, size_t n8, size_t gt, size_t ngt) {
    for (size_t i = gt; i < n8; i += ngt) { const f32x4 a = *(const f32x4*)(src + i * 8), b = *(const f32x4*)(src + i * 8 + 4);
        u32x4 o; o.x = pk2(a[0], a[1]); o.y = pk2(a[2], a[3]); o.z = pk2(b[0], b[1]); o.w = pk2(b[2], b[3]); *(u32x4*)(dst + i * 8) = o; }
}

namespace pg8 {
#define PG8_LAS __attribute__((address_space(3)))
constexpr int BM = 256, BK = 64, HALF = 128, HTB = HALF * BK * 2, STAGE_BYTES = 8 * HTB, NXCD = 8, WGM = 8;
DI int lds_byte(int r, int c) { const int st = (r >> 4) * 2 + (c >> 5), rr = r & 15, cc = c & 31, ob = rr * 64 + cc * 2; return st * 1024 + (ob ^ (((ob >> 9) & 1) << 5)); }
DI void stage_rc(int b, int& R, int& C) { const int st = b / 1024, sb = b % 1024, swz = sb ^ (((sb >> 9) & 1) << 5); R = (st >> 1) * 16 + swz / 64; C = (st & 1) * 32 + (swz % 64) / 2; }
struct Unit { int pm, pn; };
struct Gemm { const bf16_t* A; const bf16_t* Bt; int M, N, K, lda, ldb; };
struct StaticOrder {
    int nM, nN, nwg, G, c;
    DI void init(int M_, int N_, int G_, int c_) { nM = M_ / BM; nN = N_ / BM; nwg = nM * nN; G = G_; c = c_; }
    DI bool next(int i, Unit& u) const {
        const long L = (long)i * G + c; if (L >= nwg) return false;
        int wgid = (int)L; { const int q = nwg / NXCD, r = nwg % NXCD, xcd = wgid % NXCD, off = wgid / NXCD; wgid = (xcd < r ? xcd * (q + 1) : r * (q + 1) + (xcd - r) * q) + off; }
        const int nig = WGM * nN, gid = wgid / nig, fm = gid * WGM, gsz = (nM - fm) < WGM ? (nM - fm) : WGM;
        u.pm = fm + ((wgid % nig) % gsz); u.pn = (wgid % nig) / gsz; return true;
    }
};
template <class Epi>
DI void gemm_phase(PG8_LAS unsigned char* lds, const Gemm g, const StaticOrder& S, const Epi& E) {
    const int tid = threadIdx.x, wid = __builtin_amdgcn_readfirstlane(tid >> 6), lane = tid & 63, wr = wid >> 2, wc = wid & 3, fr = lane & 15, fq = lane >> 4;
    const int K = g.K, nt = K / BK;
    unsigned voffA[2], voffB[2];
#pragma unroll
    for (int i = 0; i < 2; ++i) { int R, C; stage_rc(tid * 16 + i * 8192, R, C); voffA[i] = (unsigned)(R * g.lda + C) * 2u; voffB[i] = (unsigned)(R * g.ldb + C) * 2u; }
    const size_t kstep = (size_t)(BK * 2);
    const size_t hstepA = (size_t)HALF * g.lda * 2, hstepB = (size_t)HALF * g.ldb * 2;
    const size_t tstepA = 2 * hstepA, tstepB = 2 * hstepB;
    const unsigned ldsw = (unsigned)wid * 1024u;
    const int aoff = lds_byte(wr * 64 + fr, fq * 8), boff = lds_byte(wc * 32 + fr, fq * 8);
#define PG8_SA(b, h) (((b) * 2 + (h)) * HTB)
#define PG8_SB(b, h) ((4 + (b) * 2 + (h)) * HTB)
#define PG8_STAGE(bufoff, gbase, voff) do { _Pragma("unroll") for (int _i = 0; _i < 2; ++_i) \
        __builtin_amdgcn_global_load_lds((const unsigned*)((const char*)(gbase) + (voff)[_i]), (PG8_LAS unsigned*)(lds + (bufoff) + ldsw + _i * 8192), 16, 0, 0); } while (0)
#define PG8_LDA(dst, b, h) do { _Pragma("unroll") for (int m = 0; m < 4; ++m) _Pragma("unroll") for (int k = 0; k < 2; ++k) dst[m][k] = *(const PG8_LAS bf16x8*)(lds + PG8_SA(b, h) + aoff + m * 2048 + k * 1024); } while (0)
#define PG8_LDB(dst, b, h) do { _Pragma("unroll") for (int n = 0; n < 2; ++n) _Pragma("unroll") for (int k = 0; k < 2; ++k) dst[n][k] = *(const PG8_LAS bf16x8*)(lds + PG8_SB(b, h) + boff + n * 2048 + k * 1024); } while (0)
#define PG8_MMA(ai, bj, At, Bt) do { __builtin_amdgcn_s_setprio(1); _Pragma("unroll") for (int m = 0; m < 4; ++m) _Pragma("unroll") for (int n = 0; n < 2; ++n) _Pragma("unroll") for (int k = 0; k < 2; ++k) \
        acc[ai][bj][m][n] = __builtin_amdgcn_mfma_f32_16x16x32_bf16(Bt[n][k], At[m][k], acc[ai][bj][m][n], 0, 0, 0); __builtin_amdgcn_s_setprio(0); } while (0)
#define PG8_WAIT_V(n) asm volatile("s_waitcnt vmcnt(" #n ")" ::: "memory")
#define PG8_WAIT_L(n) asm volatile("s_waitcnt lgkmcnt(" #n ")" ::: "memory")
#define PG8_BAR __builtin_amdgcn_s_barrier()
#define PG8_SCHED __builtin_amdgcn_sched_barrier(0)
    Unit cur, nxt; int ui = 0;
    if (!S.next(0, cur)) return;
    f32x4 acc[2][2][4][2];
#pragma unroll
    for (int a = 0; a < 2; ++a)
#pragma unroll
        for (int b = 0; b < 2; ++b)
#pragma unroll
            for (int m = 0; m < 4; ++m)
#pragma unroll
                for (int n = 0; n < 2; ++n) acc[a][b][m][n] = (f32x4){0.f, 0.f, 0.f, 0.f};
    bf16x8 At[4][2], B0[2][2], B1[2][2];
    const char* cA = (const char*)g.A + (size_t)cur.pm * tstepA; const char* cB = (const char*)g.Bt + (size_t)cur.pn * tstepB;
    PG8_STAGE(PG8_SB(0, 0), cB, voffB); PG8_STAGE(PG8_SB(0, 1), cB + hstepB, voffB); PG8_STAGE(PG8_SA(0, 0), cA, voffA); PG8_STAGE(PG8_SA(0, 1), cA + hstepA, voffA);
    if (wr == 1) PG8_BAR;
    PG8_WAIT_V(2); PG8_BAR;
    PG8_STAGE(PG8_SB(1, 0), cB + kstep, voffB); PG8_STAGE(PG8_SA(1, 0), cA + kstep, voffA); PG8_STAGE(PG8_SB(1, 1), cB + hstepB + kstep, voffB);
    PG8_WAIT_V(6); PG8_BAR;
    for (;;) {
        const bool has_next = S.next(ui + 1, nxt);
        const char* nA = has_next ? (const char*)g.A + (size_t)nxt.pm * tstepA : cA; const char* nB = has_next ? (const char*)g.Bt + (size_t)nxt.pn * tstepB : cB;
#pragma unroll 1
        for (int t = 0; t < nt; t += 2) {
            const bool last = (t == nt - 2);
            const char* a1 = cA + (size_t)(t + 1) * kstep;
            const char* a2 = last ? nA : cA + (size_t)(t + 2) * kstep; const char* b2 = last ? nB : cB + (size_t)(t + 2) * kstep;
            const char* a3 = a2 + kstep; const char* b3 = b2 + kstep;
            PG8_LDB(B0, 0, 0); PG8_LDB(B1, 0, 1); PG8_SCHED; PG8_LDA(At, 0, 0); PG8_STAGE(PG8_SA(1, 1), a1 + hstepA, voffA);
            PG8_WAIT_V(8); PG8_WAIT_L(0); PG8_BAR; PG8_MMA(0, 0, At, B0); PG8_MMA(0, 1, At, B1); PG8_BAR; PG8_SCHED;
            PG8_LDA(At, 0, 1); PG8_STAGE(PG8_SB(0, 0), b2, voffB); PG8_STAGE(PG8_SB(0, 1), b2 + hstepB, voffB); PG8_STAGE(PG8_SA(0, 0), a2, voffA);
            PG8_WAIT_V(8); PG8_WAIT_L(0); PG8_BAR; PG8_MMA(1, 0, At, B0); PG8_MMA(1, 1, At, B1); PG8_BAR; PG8_SCHED;
            PG8_LDB(B0, 1, 0); PG8_LDB(B1, 1, 1); PG8_SCHED; PG8_LDA(At, 1, 0); PG8_STAGE(PG8_SA(0, 1), a2 + hstepA, voffA);
            PG8_WAIT_V(8); PG8_WAIT_L(0); PG8_BAR; PG8_MMA(0, 0, At, B0); PG8_MMA(0, 1, At, B1); PG8_BAR; PG8_SCHED;
            PG8_LDA(At, 1, 1); PG8_STAGE(PG8_SB(1, 0), b3, voffB); PG8_STAGE(PG8_SB(1, 1), b3 + hstepB, voffB); PG8_STAGE(PG8_SA(1, 0), a3, voffA);
            PG8_WAIT_V(8); PG8_WAIT_L(0); PG8_BAR; PG8_MMA(1, 0, At, B0); PG8_MMA(1, 1, At, B1); PG8_BAR; PG8_SCHED;
        }
        if (wr == 0) PG8_BAR;
        {
            const int row0 = cur.pm * BM + wr * 64 + fr, col0 = cur.pn * BM + wc * 32 + 4 * fq;
#pragma unroll
            for (int ai = 0; ai < 2; ++ai)
#pragma unroll
                for (int m = 0; m < 4; ++m)
#pragma unroll
                    for (int n = 0; n < 2; ++n) E(row0 + ai * HALF + m * 16, col0 + n * 16, acc[ai][0][m][n], acc[ai][1][m][n]);
        }
        if (!has_next) break;
#pragma unroll
        for (int a = 0; a < 2; ++a)
#pragma unroll
            for (int b = 0; b < 2; ++b)
#pragma unroll
                for (int m = 0; m < 4; ++m)
#pragma unroll
                    for (int n = 0; n < 2; ++n) acc[a][b][m][n] = (f32x4){0.f, 0.f, 0.f, 0.f};
        cur = nxt; cA = nA; cB = nB; ++ui;
        if (wr == 1) PG8_BAR;
    }
    PG8_WAIT_V(0);
    PG8_BAR;
#undef PG8_SA
#undef PG8_SB
#undef PG8_STAGE
#undef PG8_LDA
#undef PG8_LDB
#undef PG8_MMA
#undef PG8_WAIT_V
#undef PG8_WAIT_L
#undef PG8_BAR
#undef PG8_SCHED
}
}
template <class Epi>
DI void gemm_run(unsigned char* lds, const bf16_t* A, int lda, const bf16_t* Bt, int ldb, int Mm, int N, int K, const Epi& E) {
    pg8::Gemm g{A, Bt, Mm, N, K, lda, ldb}; pg8::StaticOrder S; S.init(Mm, N, (int)gridDim.x, (int)blockIdx.x);
    pg8::gemm_phase((PG8_LAS unsigned char*)lds, g, S, E);
}

struct EpiProjA { bf16_t* O; float* AB;
    DI void operator()(int r, int c, f32x4 a, f32x4 b) const { bf16_t* o = O + (size_t)r * NA + c; st4(o, a); st4(o + 128, b);
        if (c >= 3072 && c < 3088) *(f32x4*)(AB + (size_t)r * 16 + (c - 3072)) = a; } };
struct EpiStore { bf16_t* O; int ldo;
    DI void operator()(int r, int c, f32x4 a, f32x4 b) const { bf16_t* o = O + (size_t)r * ldo + c; st4(o, a); st4(o + 128, b); } };
struct EpiQ { bf16_t* O;
    DI void operator()(int r, int c, f32x4 a, f32x4 b) const { bf16_t* o = O + (size_t)r * 1536 + c; st4(o, a * C2); st4(o + 128, b * C2); } };
struct EpiKV { bf16_t* KN; bf16_t* V;
    DI void one(int r, int c, f32x4 v) const { if (c < 1024) st4(KN + (size_t)r * 1024 + c, v); else st4(V + (size_t)r * 1024 + c - 1024, v); }
    DI void operator()(int r, int c, f32x4 a, f32x4 b) const { one(r, c, a); one(r, c + 128, b); } };
struct EpiYdn { bf16_t* P;
    DI void one(int r, int c, f32x4 v) const { bf16_t* g = P + (size_t)r * NB + 1024 + c; const f32x4 gv = ld4(g);
        st4(g, (f32x4){sigm(gv[0]) * v[0], sigm(gv[1]) * v[1], sigm(gv[2]) * v[2], sigm(gv[3]) * v[3]}); }
    DI void operator()(int r, int c, f32x4 a, f32x4 b) const { one(r, c, a); one(r, c + 128, b); } };
struct EpiYmla { bf16_t* P;
    DI void one(int r, int c, f32x4 v) const { bf16_t* g = P + (size_t)r * NB + 2048 + c; const f32x4 gv = ld4(g), tv = ld4(g - 1024);
        st4(g, (f32x4){tv[0] + sigm(gv[0]) * v[0], tv[1] + sigm(gv[1]) * v[1], tv[2] + sigm(gv[2]) * v[2], tv[3] + sigm(gv[3]) * v[3]}); }
    DI void operator()(int r, int c, f32x4 a, f32x4 b) const { one(r, c, a); one(r, c + 128, b); } };
struct EpiWo { const float* x; float* T1;
    DI void one(int r, int c, f32x4 v) const { const size_t o = (size_t)r * D + c; *(f32x4*)(T1 + o) = *(const f32x4*)(x + o) * ALPHA + v; }
    DI void operator()(int r, int c, f32x4 a, f32x4 b) const { one(r, c, a); one(r, c + 128, b); } };
struct EpiFfnIn { bf16_t* ACT;
    DI void operator()(int r, int c, f32x4 a, f32x4 b) const { const int t = c >> 8, j = c & 255;
        st4(ACT + (size_t)r * FF + 128 * t + j, (f32x4){silu(a[0]) * b[0], silu(a[1]) * b[1], silu(a[2]) * b[2], silu(a[3]) * b[3]}); } };
struct EpiSg { bf16_t* SG;
    DI void one(int r, int c, f32x4 v) const { st4(SG + (size_t)r * D + c, (f32x4){sigm(v[0]), sigm(v[1]), sigm(v[2]), sigm(v[3])}); }
    DI void operator()(int r, int c, f32x4 a, f32x4 b) const { one(r, c, a); one(r, c + 128, b); } };
struct EpiPle { bf16_t* SG;
    DI void one(int r, int c, f32x4 v) const { bf16_t* g = SG + (size_t)r * D + c; st4(g, ld4(g) * v); }
    DI void operator()(int r, int c, f32x4 a, f32x4 b) const { one(r, c, a); one(r, c + 128, b); } };
struct EpiFfnOut { float* H1; const bf16_t* PLE;
    DI void one(int r, int c, f32x4 v) const { const size_t o = (size_t)r * D + c; *(f32x4*)(H1 + o) = *(const f32x4*)(H1 + o) * ALPHA + v + ld4(PLE + o); }
    DI void operator()(int r, int c, f32x4 a, f32x4 b) const { one(r, c, a); one(r, c + 128, b); } };

DI void p2_tokens(const Params& P, int gw, int ngw, int lane) {
    unsigned char* ws = P.ws;
    const bf16_t* PA = (const bf16_t*)(ws + O_PROJA); const float* AB = (const float*)(ws + O_AB);
    bf16_t* DQ = (bf16_t*)P.out; bf16_t* DK = DQ + (size_t)M * 1024; bf16_t* DV = (bf16_t*)(ws + O_DV);
    float* BETA = (float*)(ws + O_BETA); float* GG = (float*)(ws + O_GG);
    bf16_t* CQ = (bf16_t*)(ws + O_CQ); bf16_t* CKV = (bf16_t*)(ws + O_CKV); bf16_t* KR = (bf16_t*)(ws + O_KR);
    for (int m = gw; m < M; m += ngw) {
        const int s = m % S;
        const bf16_t* row = PA + (size_t)m * NA;
        for (int hg = 0; hg < 24; ++hg) {
            const int c = hg * 128 + 2 * lane;
            float a0 = 0.f, a1 = 0.f;
#pragma unroll
            for (int i = 0; i < 4; ++i) { if (s - 3 + i >= 0) { const unsigned u = *(const unsigned*)(row + (ptrdiff_t)(i - 3) * NA + c); const f32x2 w = *(const f32x2*)(P.conv_w + i * 3072 + c);
                a0 += w.x * bflo(u); a1 += w.y * bfhi(u); } }
            a0 = silu(a0); a1 = silu(a1);
            if (hg < 16) { const float ss = wave_sum(a0 * a0 + a1 * a1); float r = rsqrtf(ss + 1e-6f); if (hg < 8) r *= 0.08838834764831845f; a0 *= r; a1 *= r; }
            bf16_t* dst = hg < 8 ? DQ : (hg < 16 ? DK : DV);
            *(unsigned*)(dst + (size_t)m * 1024 + (hg & 7) * 128 + 2 * lane) = pk2(a0, a1);
        }
        if (lane < 8) { const float br = AB[(size_t)m * 16 + lane], ar = AB[(size_t)m * 16 + 8 + lane];
            BETA[(size_t)m * 8 + lane] = sigm(br);
            const float xx = ar + P.dt_bias[lane]; const float sp = fmaxf(xx, 0.f) + log1pf(__expf(-fabsf(xx)));
            GG[(size_t)m * 8 + lane] = -__expf(P.a_log[lane]) * sp; }
        {
            float v[6]; float ss = 0.f;
#pragma unroll
            for (int j = 0; j < 3; ++j) { const unsigned u = *(const unsigned*)(row + 3088 + 128 * j + 2 * lane); v[2 * j] = bflo(u); v[2 * j + 1] = bfhi(u); ss += v[2 * j] * v[2 * j] + v[2 * j + 1] * v[2 * j + 1]; }
            const float r = rsqrtf(wave_sum(ss) * (1.f / 384.f) + 1e-6f);
#pragma unroll
            for (int j = 0; j < 3; ++j) { const int idx = 128 * j + 2 * lane; *(unsigned*)(CQ + (size_t)m * 384 + idx) = pk2(v[2 * j] * r * P.q_norm_w[idx], v[2 * j + 1] * r * P.q_norm_w[idx + 1]); }
        }
        {
            float v[4]; float ss = 0.f;
#pragma unroll
            for (int j = 0; j < 2; ++j) { const unsigned u = *(const unsigned*)(row + 3472 + 128 * j + 2 * lane); v[2 * j] = bflo(u); v[2 * j + 1] = bfhi(u); ss += v[2 * j] * v[2 * j] + v[2 * j + 1] * v[2 * j + 1]; }
            const float r = rsqrtf(wave_sum(ss) * (1.f / 256.f) + 1e-6f);
#pragma unroll
            for (int j = 0; j < 2; ++j) { const int idx = 128 * j + 2 * lane; *(unsigned*)(CKV + (size_t)m * 256 + idx) = pk2(v[2 * j] * r * P.kv_norm_w[idx], v[2 * j + 1] * r * P.kv_norm_w[idx + 1]); }
        }
        if (lane < 32) { const float t1 = bf2f(row[3728 + lane]), t2 = bf2f(row[3728 + 32 + lane]); float c, sn; rope_cs(P.pos[m], lane, c, sn);
            *(unsigned*)(KR + (size_t)m * 64 + 2 * lane) = pk2(t1 * c - t2 * sn, t2 * c + t1 * sn); }
    }
}

typedef float f32x16 __attribute__((ext_vector_type(16)));
typedef short s16x4 __attribute__((ext_vector_type(4)));
#define LAS __attribute__((address_space(3)))
typedef LAS unsigned char* lptr;
DI s16x4 vtr(lptr p) { return __builtin_bit_cast(s16x4, __builtin_amdgcn_ds_read_tr16_b64_v4i16((LAS s16x4*)p)); }
#define MFMA32(a, b, c) __builtin_amdgcn_mfma_f32_32x32x16_bf16((a), (b), (c), 0, 0, 0)
DI bf16x8 pack8(const f32x16& x, int o) { u32x4 p; p.x = pk2(x[o], x[o + 1]); p.y = pk2(x[o + 2], x[o + 3]); p.z = pk2(x[o + 4], x[o + 5]); p.w = pk2(x[o + 6], x[o + 7]); return __builtin_bit_cast(bf16x8, p); }
DI void attn_fast(const Params& P, unsigned char* lds_) {
    lptr lds = (lptr)lds_;
    constexpr int KP = 400, VP = 272, KBUF = 64 * KP, VBUF = 64 * VP;
    unsigned char* ws = P.ws;
    const bf16_t* Qg = (const bf16_t*)(ws + O_Q); const bf16_t* KN = (const bf16_t*)(ws + O_KN); const bf16_t* V = (const bf16_t*)(ws + O_V); const bf16_t* KR = (const bf16_t*)(ws + O_KR);
    bf16_t* OM = (bf16_t*)(ws + O_OMLA);
    const int tid = threadIdx.x, lane = tid & 63, w = __builtin_amdgcn_readfirstlane(tid >> 6), r32 = lane & 31, hi = lane >> 5;
    const int G = gridDim.x, bx = blockIdx.x;
    for (int pu0 = bx; pu0 < 256; pu0 += G) {
        const int pu = (G == 256) ? ((pu0 & 7) * 32 + (pu0 >> 3)) : pu0;
        const int bh = pu >> 3, s8 = pu & 7, b = bh >> 3, h = bh & 7;
        const size_t rowb = (size_t)b * S;
        for (int half = 0; half < 2; ++half) {
            const int qb = half ? 15 - s8 : s8, q0 = qb * 256, NT = (q0 + 256) / 64;
            const int qrow = q0 + 32 * w + r32;
            bf16x8 qf[12];
            { const bf16_t* qp = Qg + (rowb + qrow) * 1536 + h * 192 + 8 * hi;
#pragma unroll
              for (int ks = 0; ks < 12; ++ks) qf[ks] = *(const bf16x8*)(qp + 16 * ks); }
            const bf16_t* kn_src = KN + (rowb + (tid >> 4)) * 1024 + h * 128 + (tid & 15) * 8;
            const bf16_t* kr_src = KR + (rowb + (tid >> 3)) * 64 + (tid & 7) * 8;
            const bf16_t* v_src = V + (rowb + (tid >> 4)) * 1024 + h * 128 + (tid & 15) * 8;
            const int kdst = (tid >> 4) * KP + (tid & 15) * 16, krdst = (tid >> 3) * KP + 256 + (tid & 7) * 16, vdst = (tid >> 4) * VP + (tid & 15) * 16;
            u32x4 st0, st1, st2, st3, st4_;
#define LOADT(kt) do { const size_t o_ = (size_t)(kt) * 64; st0 = *(const u32x4*)(kn_src + o_ * 1024); st1 = *(const u32x4*)(kn_src + (o_ + 32) * 1024); st2 = *(const u32x4*)(kr_src + o_ * 64); \
                       st3 = *(const u32x4*)(v_src + o_ * 1024); st4_ = *(const u32x4*)(v_src + (o_ + 32) * 1024); } while (0)
#define STORET(buf) do { lptr kb_ = lds + (buf) * KBUF; lptr vb_ = lds + 2 * KBUF + (buf) * VBUF; *(LAS u32x4*)(kb_ + kdst) = st0; *(LAS u32x4*)(kb_ + kdst + 32 * KP) = st1; *(LAS u32x4*)(kb_ + krdst) = st2; \
                         *(LAS u32x4*)(vb_ + vdst) = st3; *(LAS u32x4*)(vb_ + vdst + 32 * VP) = st4_; } while (0)
            __syncthreads();
            LOADT(0); STORET(0);
            __syncthreads();
            f32x16 o[4];
#pragma unroll
            for (int d = 0; d < 4; ++d)
#pragma unroll
                for (int i = 0; i < 16; ++i) o[d][i] = 0.f;
            float m_run = -1e30f, l_run = 0.f;
            for (int kt = 0; kt < NT; ++kt) {
                const int buf = kt & 1;
                if (kt + 1 < NT) LOADT(kt + 1);
                if (64 * kt <= q0 + 32 * w + 31) {
                    lptr kb = lds + buf * KBUF + r32 * KP + hi * 16;
                    f32x16 s0, s1;
#pragma unroll
                    for (int i = 0; i < 16; ++i) { s0[i] = 0.f; s1[i] = 0.f; }
#pragma unroll
                    for (int ks = 0; ks < 12; ++ks) { const bf16x8 a0 = *(const LAS bf16x8*)(kb + ks * 32), a1 = *(const LAS bf16x8*)(kb + 32 * KP + ks * 32);
                        s0 = MFMA32(a0, qf[ks], s0); s1 = MFMA32(a1, qf[ks], s1); }
                    if (64 * kt + 63 > q0 + 32 * w) {
                        const int kv0 = 64 * kt + 4 * hi;
#pragma unroll
                        for (int i = 0; i < 16; ++i) { const int kv = kv0 + (i & 3) + 8 * (i >> 2); if (kv > qrow) s0[i] = -1e30f; if (kv + 32 > qrow) s1[i] = -1e30f; }
                    }
                    float mx = fmaxf(s0[0], s1[0]);
#pragma unroll
                    for (int i = 1; i < 16; ++i) mx = fmaxf(mx, fmaxf(s0[i], s1[i]));
                    mx = fmaxf(mx, __shfl_xor(mx, 32));
                    const float m_new = fmaxf(m_run, mx), al = __builtin_amdgcn_exp2f(m_run - m_new); m_run = m_new;
                    float ps = 0.f;
#pragma unroll
                    for (int i = 0; i < 16; ++i) { s0[i] = __builtin_amdgcn_exp2f(s0[i] - m_new); s1[i] = __builtin_amdgcn_exp2f(s1[i] - m_new); ps += s0[i] + s1[i]; }
                    l_run = l_run * al + ps;
#pragma unroll
                    for (int d = 0; d < 4; ++d) o[d] = o[d] * al;
                    bf16x8 pf[4]; pf[0] = pack8(s0, 0); pf[1] = pack8(s0, 8); pf[2] = pack8(s1, 0); pf[3] = pack8(s1, 8);
                    lptr vb = lds + 2 * KBUF + buf * VBUF + (4 * hi + ((lane & 15) >> 2)) * VP + (((lane >> 4) & 1) * 16 + (lane & 3) * 4) * 2;
#pragma unroll
                    for (int s = 0; s < 4; ++s)
#pragma unroll
                        for (int d = 0; d < 4; ++d) { const s16x4 lo = vtr(vb + s * 16 * VP + d * 64), hh = vtr(vb + (s * 16 + 8) * VP + d * 64);
                            const bf16x8 a = __builtin_shufflevector(lo, hh, 0, 1, 2, 3, 4, 5, 6, 7); o[d] = MFMA32(a, pf[s], o[d]); }
                }
                if (kt + 1 < NT) STORET(buf ^ 1);
                __syncthreads();
            }
#undef LOADT
#undef STORET
            l_run += __shfl_xor(l_run, 32);
            const float il = 1.f / l_run;
            bf16_t* op = OM + (rowb + qrow) * 1024 + h * 128 + 4 * hi;
#pragma unroll
            for (int d = 0; d < 4; ++d)
#pragma unroll
                for (int g = 0; g < 4; ++g) st4(op + 32 * d + 8 * g, (f32x4){o[d][4 * g], o[d][4 * g + 1], o[d][4 * g + 2], o[d][4 * g + 3]} * il);
        }
    }
}

#define LFENCE() asm volatile("s_waitcnt lgkmcnt(0)" ::: "memory")
DI int crow(int r, int hi) { return (r & 3) + 8 * (r >> 2) + 4 * hi; }
DI void store_raw(unsigned char* p, const f32x16& x) { *(u32x4*)p = __builtin_bit_cast(u32x4, pack8(x, 0)); *(u32x4*)(p + 16) = __builtin_bit_cast(u32x4, pack8(x, 8)); }
DI void delta_A(const Params& P, unsigned char* lds_, int gw, int ngw, int lane, int wid) {
    unsigned char* ws = P.ws;
    lptr base = (lptr)lds_ + wid * 18432;
    LAS float* Lm = (LAS float*)base;
    LAS float* gc = (LAS float*)(base + 17408); LAS float* bu = gc + 64; LAS float* bw = bu + 64; LAS float* tl = bw + 64;
    bf16_t* DQ = (bf16_t*)P.out; const bf16_t* DK = DQ + (size_t)M * 1024; const bf16_t* DV = (const bf16_t*)(ws + O_DV);
    const float* BETA = (const float*)(ws + O_BETA); const float* GG = (const float*)(ws + O_GG); float* EGL = (float*)(ws + O_EGL);
    for (int ch = gw; ch < 2048; ch += ngw) {
        asm volatile("" : "+v"(lane));
        const int r32 = lane & 31, hi = lane >> 5;
        const int h = ch & 7, bn = ch >> 3, b = bn >> 6, n = bn & 63; const size_t m0 = (size_t)b * S + 64 * n;
        LFENCE();
        {
            float g = GG[(m0 + lane) * 8 + h]; const float be = BETA[(m0 + lane) * 8 + h];
#pragma unroll
            for (int o = 1; o < 64; o <<= 1) { const float t = __shfl_up(g, o); if (lane >= o) g += t; }
            const float gl = __shfl(g, 63);
            gc[lane] = g; bu[lane] = be; bw[lane] = -be * __expf(g); tl[lane] = __expf(gl - g);
            if (lane == 0) EGL[ch] = __expf(gl);
        }
        LFENCE();
        {
#pragma unroll
            for (int t = 0; t < 3; ++t) { const int ib = t == 0 ? 0 : 1, jb = t == 2 ? 1 : 0;
                asm volatile("" ::: "memory");
                f32x16 x;
#pragma unroll
                for (int i = 0; i < 16; ++i) x[i] = 0.f;
#pragma unroll
                for (int ks = 0; ks < 8; ++ks) { const bf16x8 ka = *(const bf16x8*)(DK + (m0 + 32 * ib + r32) * 1024 + h * 128 + 16 * ks + 8 * hi), kb = *(const bf16x8*)(DK + (m0 + 32 * jb + r32) * 1024 + h * 128 + 16 * ks + 8 * hi);
                    x = MFMA32(ka, kb, x); }
                const int j = 32 * jb + r32; const float gcj = gc[j];
#pragma unroll
                for (int r = 0; r < 16; ++r) { const int i = 32 * ib + crow(r, hi); Lm[i * 68 + j] = (j < i) ? bu[i] * x[r] * __expf(gc[i] - gcj) : 0.f; }
            }
#pragma unroll
            for (int r = 0; r < 16; ++r) Lm[crow(r, hi) * 68 + 32 + r32] = 0.f;
#pragma unroll
            for (int t = 0; t < 3; ++t) { const int jb = t == 2 ? 1 : 0, ib = t == 0 ? 0 : 1;
                asm volatile("" ::: "memory");
                f32x16 x;
#pragma unroll
                for (int q = 0; q < 16; ++q) x[q] = 0.f;
#pragma unroll
                for (int ks = 0; ks < 8; ++ks) { const bf16x8 ka = *(const bf16x8*)(DK + (m0 + 32 * jb + r32) * 1024 + h * 128 + 16 * ks + 8 * hi), qb = *(const bf16x8*)(DQ + (m0 + 32 * ib + r32) * 1024 + h * 128 + 16 * ks + 8 * hi);
                    x = MFMA32(ka, qb, x); }
                const int i = 32 * ib + r32; const float gci = gc[i];
#pragma unroll
                for (int r = 0; r < 16; ++r) { const int j = 32 * jb + crow(r, hi); x[r] = (j <= i) ? x[r] * __expf(gci - gc[j]) : 0.f; }
                store_raw(ws + O_INTRA + (size_t)ch * 8192 + t * 2048 + lane * 32, x);
            }
        }
        LFENCE();
        {
            Lm[lane] = (lane == 0) ? 1.f : 0.f;
            for (int i = 1; i < 64; ++i) {
                float acc = 0.f;
                for (int j = 0; j < i; j += 4) { const f32x4 l4 = *(const LAS f32x4*)(Lm + i * 68 + j);
                    acc += l4[0] * Lm[j * 68 + lane] + l4[1] * Lm[(j + 1) * 68 + lane] + l4[2] * Lm[(j + 2) * 68 + lane] + l4[3] * Lm[(j + 3) * 68 + lane]; }
                LFENCE();
                Lm[i * 68 + lane] = ((lane == i) ? 1.f : 0.f) - acc;
            }
        }
        LFENCE();
        unsigned char* tscr = ws + O_ODN + (size_t)gw * 12288 + lane * 16;
#pragma unroll
        for (int q = 0; q < 6; ++q) { const int ib = q < 2 ? 0 : 1, s = q < 2 ? q : q - 2; const int i = 32 * ib + r32;
            const LAS float* tp = Lm + i * 68 + 16 * s + 8 * hi; const f32x4 t0 = *(const LAS f32x4*)tp, t1 = *(const LAS f32x4*)(tp + 4);
            const f32x4 u0 = *(const LAS f32x4*)(bu + 16 * s + 8 * hi), u1 = *(const LAS f32x4*)(bu + 16 * s + 8 * hi + 4);
            const f32x4 w0 = *(const LAS f32x4*)(bw + 16 * s + 8 * hi), w1 = *(const LAS f32x4*)(bw + 16 * s + 8 * hi + 4);
            const f32x4 a0 = t0 * u0, a1 = t1 * u1, c0 = t0 * w0, c1 = t1 * w1;
            u32x4 pu, pw; pu.x = pk2(a0[0], a0[1]); pu.y = pk2(a0[2], a0[3]); pu.z = pk2(a1[0], a1[1]); pu.w = pk2(a1[2], a1[3]);
            pw.x = pk2(c0[0], c0[1]); pw.y = pk2(c0[2], c0[3]); pw.z = pk2(c1[0], c1[1]); pw.w = pk2(c1[2], c1[3]);
            *(u32x4*)(tscr + q * 1024) = pu; *(u32x4*)(tscr + 6144 + q * 1024) = pw; }
        const float tli = tl[r32], tli1 = tl[32 + r32], eg0 = __expf(gc[r32]), eg1 = __expf(gc[32 + r32]);
        LFENCE();
#pragma unroll 4
        for (int it = 0; it < 16; ++it) { const int idx = it * 64 + lane, row = idx >> 4, c16 = idx & 15;
            *(LAS u32x4*)(base + row * 272 + c16 * 16) = *(const u32x4*)(DV + (m0 + row) * 1024 + h * 128 + c16 * 8); }
        LFENCE();
        lptr vb = base + (8 * hi + ((lane & 15) >> 2)) * 272 + (((lane >> 4) & 1) * 16 + (lane & 3) * 4) * 2;
#pragma unroll
        for (int eb = 0; eb < 4; ++eb) {
            bf16x8 vf[4];
#pragma unroll
            for (int s = 0; s < 4; ++s) { const s16x4 lo = vtr(vb + 16 * s * 272 + eb * 64), hh = vtr(vb + (16 * s + 4) * 272 + eb * 64); vf[s] = __builtin_shufflevector(lo, hh, 0, 1, 2, 3, 4, 5, 6, 7); }
#pragma unroll
            for (int ib = 0; ib < 2; ++ib) { f32x16 x;
#pragma unroll
                for (int i = 0; i < 16; ++i) x[i] = 0.f;
#pragma unroll
                for (int s = 0; s < 4; ++s) if (ib == 1 || s < 2) x = MFMA32(*(const bf16x8*)(tscr + (ib == 0 ? s : 2 + s) * 1024), vf[s], x);
                store_raw(ws + O_U + (size_t)ch * 16384 + (eb * 2 + ib) * 2048 + lane * 32, x); }
        }
        LFENCE();
#pragma unroll 4
        for (int it = 0; it < 16; ++it) { const int idx = it * 64 + lane, row = idx >> 4, c16 = idx & 15;
            *(LAS u32x4*)(base + row * 272 + c16 * 16) = *(const u32x4*)(DK + (m0 + row) * 1024 + h * 128 + c16 * 8); }
        LFENCE();
#pragma unroll
        for (int dkb = 0; dkb < 4; ++dkb) {
            bf16x8 kf[4];
#pragma unroll
            for (int s = 0; s < 4; ++s) { const s16x4 lo = vtr(vb + 16 * s * 272 + dkb * 64), hh = vtr(vb + (16 * s + 4) * 272 + dkb * 64); kf[s] = __builtin_shufflevector(lo, hh, 0, 1, 2, 3, 4, 5, 6, 7); }
#pragma unroll
            for (int ib = 0; ib < 2; ++ib) { f32x16 x;
#pragma unroll
                for (int i = 0; i < 16; ++i) x[i] = 0.f;
#pragma unroll
                for (int s = 0; s < 4; ++s) if (ib == 1 || s < 2) x = MFMA32(kf[s], *(const bf16x8*)(tscr + 6144 + (ib == 0 ? s : 2 + s) * 1024), x);
                store_raw(ws + O_WT + (size_t)ch * 16384 + (dkb * 2 + ib) * 2048 + lane * 32, x); }
#pragma unroll
            for (int ib = 0; ib < 2; ++ib) { f32x16 x;
#pragma unroll
                for (int i = 0; i < 16; ++i) x[i] = 0.f;
                const unsigned tb = f2bf(ib ? tli1 : tli);
#pragma unroll
                for (int t = 0; t < 2; ++t) { const int rel = r32 - 16 * t - 8 * hi;
                    u32x4 d; d.x = (rel == 0 ? tb : 0u) | (rel == 1 ? tb << 16 : 0u); d.y = (rel == 2 ? tb : 0u) | (rel == 3 ? tb << 16 : 0u);
                    d.z = (rel == 4 ? tb : 0u) | (rel == 5 ? tb << 16 : 0u); d.w = (rel == 6 ? tb : 0u) | (rel == 7 ? tb << 16 : 0u);
                    x = MFMA32(__builtin_bit_cast(bf16x8, d), kf[2 * ib + t], x); }
                store_raw(ws + O_KT + (size_t)ch * 16384 + (ib * 4 + dkb) * 2048 + lane * 32, x); }
        }
        {
            u32x2 qv[4][4];
#define QD_LOAD(ib) _Pragma("unroll") for (int dkb = 0; dkb < 4; ++dkb) _Pragma("unroll") for (int g = 0; g < 4; ++g) \
                qv[dkb][g] = *(const u32x2*)(DQ + (m0 + 32 * (ib) + r32) * 1024 + h * 128 + 32 * dkb + 8 * g + 4 * hi);
#define QD_STORE(ib, e) _Pragma("unroll") for (int dkb = 0; dkb < 4; ++dkb) { u32x4 lo, hh; \
                lo.x = pk2(bflo(qv[dkb][0].x) * e, bfhi(qv[dkb][0].x) * e); lo.y = pk2(bflo(qv[dkb][0].y) * e, bfhi(qv[dkb][0].y) * e); \
                lo.z = pk2(bflo(qv[dkb][1].x) * e, bfhi(qv[dkb][1].x) * e); lo.w = pk2(bflo(qv[dkb][1].y) * e, bfhi(qv[dkb][1].y) * e); \
                hh.x = pk2(bflo(qv[dkb][2].x) * e, bfhi(qv[dkb][2].x) * e); hh.y = pk2(bflo(qv[dkb][2].y) * e, bfhi(qv[dkb][2].y) * e); \
                hh.z = pk2(bflo(qv[dkb][3].x) * e, bfhi(qv[dkb][3].x) * e); hh.w = pk2(bflo(qv[dkb][3].y) * e, bfhi(qv[dkb][3].y) * e); \
                const int o = (dkb * 2 + (ib)) * 2048 + lane * 32; \
                unsigned char* dst = (unsigned char*)DQ + (m0 + (o >> 8)) * 2048 + h * 256 + (o & 255); \
                *(u32x4*)dst = lo; *(u32x4*)(dst + 16) = hh; }
            u32x2 qw[4][4];
#pragma unroll
            for (int dkb = 0; dkb < 4; ++dkb)
#pragma unroll
                for (int g = 0; g < 4; ++g) qw[dkb][g] = *(const u32x2*)(DQ + (m0 + 32 + r32) * 1024 + h * 128 + 32 * dkb + 8 * g + 4 * hi);
            QD_LOAD(0)
            asm volatile("s_waitcnt vmcnt(0)" ::: "memory");
            QD_STORE(0, eg0)
#pragma unroll
            for (int dkb = 0; dkb < 4; ++dkb)
#pragma unroll
                for (int g = 0; g < 4; ++g) qv[dkb][g] = qw[dkb][g];
            QD_STORE(1, eg1)
#undef QD_LOAD
#undef QD_STORE
        }
    }
}
DI void unpack16(f32x16& x, const unsigned char* p) { const u32x4 a = *(const u32x4*)p, b = *(const u32x4*)(p + 16);
    x[0] = bflo(a.x); x[1] = bfhi(a.x); x[2] = bflo(a.y); x[3] = bfhi(a.y); x[4] = bflo(a.z); x[5] = bfhi(a.z); x[6] = bflo(a.w); x[7] = bfhi(a.w);
    x[8] = bflo(b.x); x[9] = bfhi(b.x); x[10] = bflo(b.y); x[11] = bfhi(b.y); x[12] = bflo(b.z); x[13] = bfhi(b.z); x[14] = bflo(b.w); x[15] = bfhi(b.w); }
DI void delta_B(const Params& P, int lane, int wid) {
    if (wid != 0) return;
    unsigned char* ws = P.ws;
    const int r32 = lane & 31, hi = lane >> 5;
    const float* EGL = (const float*)(ws + O_EGL); bf16_t* ODN = (bf16_t*)(ws + O_ODN);
    for (int u = blockIdx.x; u < 128; u += gridDim.x) {
        const int bh = u >> 2, eb = u & 3, b = bh >> 3, h = bh & 7;
        f32x16 St[4];
#pragma unroll
        for (int d = 0; d < 4; ++d)
#pragma unroll
            for (int i = 0; i < 16; ++i) St[d][i] = 0.f;
        for (int n = 0; n < 64; ++n) {
            const int ch = (b * 64 + n) * 8 + h; const size_t m0 = (size_t)b * S + 64 * n;
            const unsigned char* wt = ws + O_WT + (size_t)ch * 16384 + lane * 32;
            const unsigned char* kt = ws + O_KT + (size_t)ch * 16384 + lane * 32;
            const unsigned char* in = ws + O_INTRA + (size_t)ch * 8192 + lane * 32;
            const unsigned char* uu = ws + O_U + (size_t)ch * 16384 + (eb * 2) * 2048 + lane * 32;
            const unsigned char* qd = (const unsigned char*)P.out + m0 * 2048 + h * 256;
            const float eg = EGL[ch];
            bf16x8 Spk[8];
#pragma unroll
            for (int s = 0; s < 8; ++s) Spk[s] = pack8(St[s >> 1], 8 * (s & 1));
            f32x16 vn[2], ob[2];
            unpack16(vn[0], uu); unpack16(vn[1], uu + 2048);
#pragma unroll
            for (int i = 0; i < 16; ++i) { ob[0][i] = 0.f; ob[1][i] = 0.f; }
#pragma unroll
            for (int s = 0; s < 8; ++s)
#pragma unroll
                for (int ib = 0; ib < 2; ++ib) { const bf16x8 a = *(const bf16x8*)(wt + ((s >> 1) * 2 + ib) * 2048 + 16 * (s & 1)); vn[ib] = MFMA32(a, Spk[s], vn[ib]); }
#pragma unroll
            for (int s = 0; s < 8; ++s)
#pragma unroll
                for (int ib = 0; ib < 2; ++ib) { const int o = ((s >> 1) * 2 + ib) * 2048 + lane * 32 + 16 * (s & 1);
                    const bf16x8 a = *(const bf16x8*)(qd + (size_t)(o >> 8) * 2048 + (o & 255)); ob[ib] = MFMA32(a, Spk[s], ob[ib]); }
            bf16x8 vpk[2][2];
#pragma unroll
            for (int ib = 0; ib < 2; ++ib) { vpk[ib][0] = pack8(vn[ib], 0); vpk[ib][1] = pack8(vn[ib], 8); }
#pragma unroll
            for (int t = 0; t < 2; ++t) {
                ob[0] = MFMA32(*(const bf16x8*)(in + 0 * 2048 + 16 * t), vpk[0][t], ob[0]);
                ob[1] = MFMA32(*(const bf16x8*)(in + 1 * 2048 + 16 * t), vpk[0][t], ob[1]);
                ob[1] = MFMA32(*(const bf16x8*)(in + 2 * 2048 + 16 * t), vpk[1][t], ob[1]);
            }
#pragma unroll
            for (int ib = 0; ib < 2; ++ib)
#pragma unroll
                for (int r = 0; r < 16; ++r) ODN[(m0 + 32 * ib + crow(r, hi)) * 1024 + h * 128 + 32 * eb + r32] = (bf16_t)f2bf(ob[ib][r]);
#pragma unroll
            for (int dkb = 0; dkb < 4; ++dkb) { St[dkb] = St[dkb] * eg;
#pragma unroll
                for (int s = 0; s < 4; ++s) St[dkb] = MFMA32(*(const bf16x8*)(kt + ((s >> 1) * 4 + dkb) * 2048 + 16 * (s & 1)), vpk[s >> 1][s & 1], St[dkb]); }
        }
    }
}

DI void q_rope_pass(const Params& P, size_t gt, size_t ngt) {
    bf16_t* Q = (bf16_t*)(P.ws + O_Q);
    for (size_t idx = gt; idx < (size_t)M * 8 * 32; idx += ngt) {
        const int i = (int)(idx & 31), h = (int)((idx >> 5) & 7); const size_t m = idx >> 8;
        unsigned* q = (unsigned*)(Q + m * 1536 + h * 192 + 128 + 2 * i); const unsigned u = *q; const float t1 = bflo(u), t2 = bfhi(u);
        float c, s; rope_cs(P.pos[m], i, c, s);
        *q = pk2(t1 * c - t2 * s, t2 * c + t1 * s);
    }
}

DI void p9_normgate(const Params& P, int gw, int ngw, int lane) {
    unsigned char* ws = P.ws;
    const bf16_t* ODN = (const bf16_t*)(ws + O_ODN); const bf16_t* PB = (const bf16_t*)(ws + O_PROJB); bf16_t* OG = (bf16_t*)P.out + (size_t)M * 1024;
    const float w0 = P.dn_norm_w[2 * lane], w1 = P.dn_norm_w[2 * lane + 1];
    for (int m = gw; m < M; m += ngw) {
#pragma unroll
        for (int h = 0; h < 8; ++h) {
            const unsigned u = *(const unsigned*)(ODN + (size_t)m * 1024 + h * 128 + 2 * lane); const float o0 = bflo(u), o1 = bfhi(u);
            const float r = rsqrtf(wave_sum(o0 * o0 + o1 * o1) * (1.f / 128.f) + 1e-6f);
            const unsigned z = *(const unsigned*)(PB + (size_t)m * NB + h * 128 + 2 * lane);
            *(unsigned*)(OG + (size_t)m * 1024 + h * 128 + 2 * lane) = pk2(o0 * r * w0 * silu(bflo(z)), o1 * r * w1 * silu(bfhi(z)));
        }
    }
}
DI void ln_rows(const float* __restrict__ in, float* __restrict__ outf, bf16_t* __restrict__ outb, const float* g, const float* bta, int gw, int ngw, int lane) {
    for (int m = gw; m < M; m += ngw) {
        const f32x4* xr = (const f32x4*)(in + (size_t)m * D) + lane;
        f32x4 v[4]; float s = 0.f;
#pragma unroll
        for (int j = 0; j < 4; ++j) { v[j] = xr[64 * j]; s += (v[j][0] + v[j][1]) + (v[j][2] + v[j][3]); }
        const float mean = wave_sum(s) * (1.f / D); float s2 = 0.f;
#pragma unroll
        for (int j = 0; j < 4; ++j) { v[j] = v[j] - mean; s2 += (v[j][0] * v[j][0] + v[j][1] * v[j][1]) + (v[j][2] * v[j][2] + v[j][3] * v[j][3]); }
        const float rstd = rsqrtf(wave_sum(s2) * (1.f / D) + 1e-5f);
#pragma unroll
        for (int j = 0; j < 4; ++j) { const int c = 4 * lane + 256 * j; const f32x4 gg = *(const f32x4*)(g + c), bb = *(const f32x4*)(bta + c); const f32x4 o = v[j] * rstd * gg + bb;
            *(f32x4*)(outf + (size_t)m * D + c) = o; if (outb) st4(outb + (size_t)m * D + c, o); }
    }
}

constexpr int NPH = 20;
__global__ void __launch_bounds__(NTHREADS, 2) mega(Params P) {
    extern __shared__ __attribute__((aligned(16))) unsigned char lds[];
    cg::grid_group grid = cg::this_grid();
    const int tid = threadIdx.x, lane = tid & 63, wid = tid >> 6;
    const int gw = blockIdx.x * NWAVES + wid, ngw = gridDim.x * NWAVES;
    const size_t gt = (size_t)blockIdx.x * NTHREADS + tid, ngt = (size_t)gridDim.x * NTHREADS;
    unsigned char* ws = P.ws;
    bf16_t* WIN = (bf16_t*)(ws + W_IN);
    bf16_t* XB = (bf16_t*)P.out;
#define PH_BEGIN(k) if (P.ph_lo <= (k) && (k) < P.ph_hi) {
#define PH_END(k) if ((k) + 1 < P.ph_hi) grid.sync(); }
    PH_BEGIN(0) {
            transpose_mat(P.w_in, 1024, 6864, WIN, NIN, 1, gw, ngw, lane);
            transpose_mat(P.w_uq, 384, 1536, (bf16_t*)(ws + W_UQ), 1536, 4, gw, ngw, lane);
            transpose_mat(P.w_uk, 256, 1024, (bf16_t*)(ws + W_UKV), 1024, 0, gw, ngw, lane);
            transpose_mat(P.w_uv, 256, 1024, (bf16_t*)(ws + W_UKV) + (size_t)1024 * 256, 1024, 0, gw, ngw, lane);
            transpose_mat(P.w_br_dn, 1024, 1024, (bf16_t*)(ws + W_BRDN), 1024, 0, gw, ngw, lane);
            transpose_mat(P.w_br_mla, 1024, 1024, (bf16_t*)(ws + W_BRMLA), 1024, 0, gw, ngw, lane);
            transpose_mat(P.w_o, 1024, 1024, (bf16_t*)(ws + W_O), 1024, 0, gw, ngw, lane);
            transpose_mat(P.w_ffn_in, 1024, 5632, (bf16_t*)(ws + W_FFNIN), 5632, 3, gw, ngw, lane);
            transpose_mat(P.w_ffn_out, FF, 1024, (bf16_t*)(ws + W_FFNOUT), 1024, 0, gw, ngw, lane);
            transpose_mat(P.w_ple_gate, 1024, 1024, (bf16_t*)(ws + W_PG), 1024, 0, gw, ngw, lane);
            transpose_mat(P.w_ple, 256, 1024, (bf16_t*)(ws + W_PLE), 1024, 0, gw, ngw, lane);
            cvt_rows(P.x, XB, (size_t)M * D / 8, gt, ngt);
        } PH_END(0)
    PH_BEGIN(1) { EpiProjA E{(bf16_t*)(ws + O_PROJA), (float*)(ws + O_AB)}; gemm_run(lds, XB, 1024, WIN, 1024, M, NA, 1024, E); } PH_END(1)
    PH_BEGIN(2) p2_tokens(P, gw, ngw, lane); PH_END(2)
    PH_BEGIN(3) delta_A(P, lds, gw, ngw, lane, wid); PH_END(3)
    PH_BEGIN(4) delta_B(P, lane, wid); PH_END(4)
    PH_BEGIN(5) { EpiQ E{(bf16_t*)(ws + O_Q)}; gemm_run(lds, (const bf16_t*)(ws + O_CQ), 384, (const bf16_t*)(ws + W_UQ), 384, M, 1536, 384, E); } PH_END(5)
    PH_BEGIN(6) { EpiKV E{(bf16_t*)(ws + O_KN), (bf16_t*)(ws + O_V)}; gemm_run(lds, (const bf16_t*)(ws + O_CKV), 256, (const bf16_t*)(ws + W_UKV), 256, M, 2048, 256, E); q_rope_pass(P, gt, ngt); } PH_END(6)
    PH_BEGIN(7) attn_fast(P, lds); PH_END(7)
    PH_BEGIN(8) cvt_rows(P.x, XB, (size_t)M * D / 8, gt, ngt); PH_END(8)
    PH_BEGIN(9) { EpiStore E{(bf16_t*)(ws + O_PROJB), NB}; gemm_run(lds, XB, 1024, WIN + (size_t)NA * 1024, 1024, M, NB, 1024, E); } PH_END(9)
    PH_BEGIN(10) p9_normgate(P, gw, ngw, lane); PH_END(10)
    PH_BEGIN(11) { EpiYdn E{(bf16_t*)(ws + O_PROJB)}; gemm_run(lds, (const bf16_t*)P.out + (size_t)M * 1024, 1024, (const bf16_t*)(ws + W_BRDN), 1024, M, 1024, 1024, E); } PH_END(11)
    PH_BEGIN(12) { EpiYmla E{(bf16_t*)(ws + O_PROJB)}; gemm_run(lds, (const bf16_t*)(ws + O_OMLA), 1024, (const bf16_t*)(ws + W_BRMLA), 1024, M, 1024, 1024, E); } PH_END(12)
    PH_BEGIN(13) { EpiWo E{P.x, P.out}; gemm_run(lds, (const bf16_t*)(ws + O_PROJB) + 2048, NB, (const bf16_t*)(ws + W_O), 1024, M, 1024, 1024, E); } PH_END(13)
    PH_BEGIN(14) { ln_rows(P.out, (float*)(ws + O_H1), (bf16_t*)(ws + O_H1B), P.ln1_g, P.ln1_b, gw, ngw, lane);
                   cvt_rows(P.p, (bf16_t*)(ws + O_PB), (size_t)M * 256 / 8, gt, ngt); } PH_END(14)
    PH_BEGIN(15) { EpiFfnIn E{(bf16_t*)(ws + O_ACT)}; gemm_run(lds, (const bf16_t*)(ws + O_H1B), 1024, (const bf16_t*)(ws + W_FFNIN), 1024, M, 5632, 1024, E); } PH_END(15)
    PH_BEGIN(16) { EpiSg E{(bf16_t*)P.out}; gemm_run(lds, (const bf16_t*)(ws + O_H1B), 1024, (const bf16_t*)(ws + W_PG), 1024, M, 1024, 1024, E); } PH_END(16)
    PH_BEGIN(17) { EpiPle E{(bf16_t*)P.out}; gemm_run(lds, (const bf16_t*)(ws + O_PB), 256, (const bf16_t*)(ws + W_PLE), 256, M, 1024, 256, E); } PH_END(17)
    PH_BEGIN(18) { EpiFfnOut E{(float*)(ws + O_H1), (const bf16_t*)P.out}; gemm_run(lds, (const bf16_t*)(ws + O_ACT), FF, (const bf16_t*)(ws + W_FFNOUT), FF, M, 1024, FF, E); } PH_END(18)
    PH_BEGIN(19) ln_rows((const float*)(ws + O_H1), P.out, nullptr, P.ln2_g, P.ln2_b, gw, ngw, lane); PH_END(19)
}

extern "C" void kernel_launch(void* const* d_in, const int* in_sizes, int n_in, void* d_out, int out_size, void* d_ws, size_t ws_size, hipStream_t stream) {
    static int grid = 0;
    if (grid == 0) {
        int dev = 0, cus = 0, per_cu = 0;
        (void)hipGetDevice(&dev);
        (void)hipDeviceGetAttribute(&cus, hipDeviceAttributeMultiprocessorCount, dev);
        (void)hipFuncSetAttribute((const void*)mega, hipFuncAttributeMaxDynamicSharedMemorySize, LDS_BYTES);
        (void)hipOccupancyMaxActiveBlocksPerMultiprocessor(&per_cu, (const void*)mega, NTHREADS, LDS_BYTES);
        if (per_cu < 1) per_cu = 1;
        grid = cus * per_cu;
        if (ws_size < 256 * MiB) { fprintf(stderr, "workspace too small: %zu\n", ws_size); grid = -1; }
    }
    if (grid < 0) return;
    Params P{};
    const float** pf = (const float**)&P;
    for (int i = 0; i < 24; ++i) pf[i] = (const float*)d_in[i];
    P.out = (float*)d_out; P.ws = (unsigned char*)d_ws;
#if NLAUNCH == 1
    P.ph_lo = 0; P.ph_hi = NPH;
    { void* args[] = {&P}; hipError_t e = hipLaunchCooperativeKernel((const void*)mega, dim3(grid), dim3(NTHREADS), args, LDS_BYTES, stream);
      if (e != hipSuccess) fprintf(stderr, "cooperative launch failed: %s\n", hipGetErrorString(e)); }
#else
    for (int ph = 0; ph < NPH; ++ph) { P.ph_lo = ph; P.ph_hi = ph + 1; void* args[] = {&P};
        hipError_t e = hipLaunchCooperativeKernel((const void*)mega, dim3(grid), dim3(NTHREADS), args, LDS_BYTES, stream);
        if (e != hipSuccess) { fprintf(stderr, "cooperative launch failed: %s\n", hipGetErrorString(e)); break; } }
#endif
}
```

```cpp
#include <hip/hip_runtime.h>
#include <hip/hip_cooperative_groups.h>
#include <cstdint>
#include <cstdio>
namespace cg = cooperative_groups;

#define DI __device__ __forceinline__
typedef unsigned short bf16_t;
typedef short bf16x8 __attribute__((ext_vector_type(8)));
typedef float f32x4 __attribute__((ext_vector_type(4)));
typedef float f32x2 __attribute__((ext_vector_type(2)));
typedef unsigned u32x4 __attribute__((ext_vector_type(4)));
typedef unsigned u32x2 __attribute__((ext_vector_type(2)));

#ifndef NLAUNCH
#define NLAUNCH 1
#endif

constexpr int Bn = 4, S = 4096, D = 1024, M = Bn * S;
constexpr int NA = 3840, NB = 3072, NIN = NA + NB;
constexpr int FF = 2816;
constexpr int NTHREADS = 512, NWAVES = 8;
constexpr int LDS_BYTES = 147456;
constexpr float ALPHA = 1.189207115002721f;
constexpr float C2 = 0.07216878364870322f * 1.4426950408889634f;

constexpr size_t MiB = 1u << 20;
constexpr size_t W_IN = 0, W_UQ = W_IN + (size_t)NIN * 1024 * 2, W_UKV = W_UQ + (size_t)1536 * 384 * 2, W_BRDN = W_UKV + (size_t)2048 * 256 * 2,
                 W_BRMLA = W_BRDN + 2 * MiB, W_O = W_BRMLA + 3 * MiB, W_FFNIN = W_O + 2 * MiB, W_FFNOUT = W_FFNIN + (size_t)5632 * 1024 * 2,
                 W_PG = W_FFNOUT + (size_t)1024 * FF * 2, W_PLE = W_PG + 2 * MiB, W_END = W_PLE + (size_t)1024 * 256 * 2;
static_assert(W_END <= 41 * MiB + 768 * 1024, "weights");
constexpr size_t O_BAR = 41 * MiB + 768 * 1024;
constexpr size_t O_AB = 42 * MiB, O_EGL = O_AB, O_BETA = 43 * MiB, O_GG = 43 * MiB + MiB / 2, O_CQ = 44 * MiB, O_PB = O_CQ, O_CKV = 56 * MiB, O_KR = 64 * MiB;
constexpr size_t ARENA = 66 * MiB;
constexpr size_t O_PROJA = ARENA, O_DV = 224 * MiB;
constexpr size_t O_WT = ARENA, O_INTRA = ARENA + 32 * MiB, O_Q = ARENA + 44 * MiB, O_KN = ARENA + 92 * MiB, O_V = ARENA + 124 * MiB;
constexpr size_t O_Z = ARENA, O_GD = O_KN, O_GM = O_V;
constexpr size_t O_H1 = ARENA, O_H1B = ARENA + 64 * MiB, O_ACT = ARENA + 96 * MiB;
static_assert(O_V + 32 * MiB <= O_DV && O_PROJA + 120 * MiB <= O_DV && O_ACT + 88 * MiB <= 256 * MiB && O_DV + 32 * MiB <= 256 * MiB, "ws map");

struct Params {
    const float* x; const float* p; const int* pos; const float* w_in; const float* conv_w; const float* a_log; const float* dt_bias; const float* dn_norm_w;
    const float* q_norm_w; const float* w_uq; const float* kv_norm_w; const float* w_uk; const float* w_uv; const float* w_br_dn; const float* w_br_mla; const float* w_o;
    const float* ln1_g; const float* ln1_b; const float* w_ffn_in; const float* w_ffn_out; const float* w_ple; const float* w_ple_gate; const float* ln2_g; const float* ln2_b;
    float* out; unsigned char* ws; int ph_lo, ph_hi;
};

DI unsigned f2bf(float f) { unsigned u = __float_as_uint(f); return (u + 0x7fffu + ((u >> 16) & 1u)) >> 16; }
DI unsigned pk2(float lo, float hi) { return f2bf(lo) | (f2bf(hi) << 16); }
DI float bflo(unsigned u) { return __uint_as_float(u << 16); }
DI float bfhi(unsigned u) { return __uint_as_float(u & 0xffff0000u); }
DI float bf2f(bf16_t b) { return __uint_as_float(((unsigned)b) << 16); }
DI float sigm(float x) { return 1.f / (1.f + __expf(-x)); }
DI float silu(float x) { return x / (1.f + __expf(-x)); }
DI float wave_sum(float v) {
#pragma unroll
    for (int o = 1; o < 64; o <<= 1) v += __shfl_xor(v, o);
    return v;
}
DI float wave_max(float v) {
#pragma unroll
    for (int o = 1; o < 64; o <<= 1) v = fmaxf(v, __shfl_xor(v, o));
    return v;
}
DI void st4(bf16_t* p, f32x4 v) { u32x2 w; w.x = pk2(v[0], v[1]); w.y = pk2(v[2], v[3]); *(u32x2*)p = w; }
DI f32x4 ld4(const bf16_t* p) { const u32x2 w = *(const u32x2*)p; return (f32x4){bflo(w.x), bfhi(w.x), bflo(w.y), bfhi(w.y)}; }
DI void rope_cs(int pos, int i, float& c, float& s) {
    const float inv = exp2f(-(float)i * (13.287712379549449f / 32.f));
    const float ang = (float)pos * inv;
    const double a = (double)ang; const double k = rint(a * 0.15915494309189535); const float r = (float)(a - k * 6.283185307179586);
    c = __cosf(r); s = __sinf(r);
}

DI void transpose_mat(const float* __restrict__ W, int K, int ldw, bf16_t* __restrict__ WT, int nrows, int mode, int gw, int ngw, int lane) {
    const int nkb = K / 64, nitems = (nrows / 64) * nkb;
    for (int it = gw; it < nitems; it += ngw) {
        const int nb = it / nkb, kb = it % nkb, n = nb * 64 + lane;
        int sc = n;
        if (mode == 1) { if (n < 3072) sc = n; else if (n < 3792) sc = n + 1024; else if (n < 3840) sc = -1; else { const int nn = n - 3840; sc = nn < 1024 ? nn + 3072 : nn + 3792; } }
        else if (mode == 3) { const int t = n >> 8, w = n & 255; sc = w < 128 ? 128 * t + w : 2816 + 128 * t + (w - 128); }
        else if (mode == 4) { const int h = n / 192, d = n % 192; if (d >= 128) { const int r = d - 128; sc = h * 192 + 128 + (r >> 1) + 32 * (r & 1); } }
#pragma unroll 2
        for (int c = 0; c < 8; ++c) {
            const int k0 = kb * 64 + c * 8; float v[8];
            int kr = k0; bool kz = false; if (mode == 5) { const int hh = k0 / 192, d0 = k0 % 192; kz = d0 >= 128; kr = hh * 128 + d0; }
#pragma unroll
            for (int j = 0; j < 8; ++j) v[j] = (sc >= 0 && !kz) ? W[(size_t)(kr + j) * ldw + sc] : 0.f;
            u32x4 o; o.x = pk2(v[0], v[1]); o.y = pk2(v[2], v[3]); o.z = pk2(v[4], v[5]); o.w = pk2(v[6], v[7]);
            *(u32x4*)(WT + (size_t)n * K + k0) = o;
        }
    }
}
DI void cvt_rows(const float* __restrict__ src, bf16_t* __restrict__ dst, size_t n8, size_t gt, size_t ngt) {
    for (size_t i = gt; i < n8; i += ngt) { const f32x4 a = *(const f32x4*)(src + i * 8), b = *(const f32x4*)(src + i * 8 + 4);
        u32x4 o; o.x = pk2(a[0], a[1]); o.y = pk2(a[2], a[3]); o.z = pk2(b[0], b[1]); o.w = pk2(b[2], b[3]); *(u32x4*)(dst + i * 8) = o; }
}

namespace pg8 {
#define PG8_LAS __attribute__((address_space(3)))
constexpr int BM = 256, BK = 64, HALF = 128, HTB = HALF * BK * 2, STAGE_BYTES = 8 * HTB, NXCD = 8, WGM = 8;
DI int lds_byte(int r, int c) { const int st = (r >> 4) * 2 + (c >> 5), rr = r & 15, cc = c & 31, ob = rr * 64 + cc * 2; return st * 1024 + (ob ^ (((ob >> 9) & 1) << 5)); }
DI void stage_rc(int b, int& R, int& C) { const int st = b / 1024, sb = b % 1024, swz = sb ^ (((sb >> 9) & 1) << 5); R = (st >> 1) * 16 + swz / 64; C = (st & 1) * 32 + (swz % 64) / 2; }
struct Unit { int pm, pn; };
struct Gemm { const bf16_t* A; const bf16_t* Bt; int M, N, K, lda, ldb; };
struct StaticOrder {
    int nM, nN, nwg, G, c;
    DI void init(int M_, int N_, int G_, int c_) { nM = M_ / BM; nN = N_ / BM; nwg = nM * nN; G = G_; c = c_; }
    DI bool next(int i, Unit& u) const {
        const long L = (long)i * G + c; if (L >= nwg) return false;
        int wgid = (int)L; { const int q = nwg / NXCD, r = nwg % NXCD, xcd = wgid % NXCD, off = wgid / NXCD; wgid = (xcd < r ? xcd * (q + 1) : r * (q + 1) + (xcd - r) * q) + off; }
        const int nig = WGM * nN, gid = wgid / nig, fm = gid * WGM, gsz = (nM - fm) < WGM ? (nM - fm) : WGM;
        u.pm = fm + ((wgid % nig) % gsz); u.pn = (wgid % nig) / gsz; return true;
    }
};
template <class Epi>
DI void gemm_phase(PG8_LAS unsigned char* lds, const Gemm g, const StaticOrder& S, const Epi& E) {
    const int tid = threadIdx.x, wid = __builtin_amdgcn_readfirstlane(tid >> 6), lane = tid & 63, wr = wid >> 2, wc = wid & 3, fr = lane & 15, fq = lane >> 4;
    const int K = g.K, nt = K / BK;
    unsigned voffA[2], voffB[2];
#pragma unroll
    for (int i = 0; i < 2; ++i) { int R, C; stage_rc(tid * 16 + i * 8192, R, C); voffA[i] = (unsigned)(R * g.lda + C) * 2u; voffB[i] = (unsigned)(R * g.ldb + C) * 2u; }
    const size_t kstep = (size_t)(BK * 2);
    const size_t hstepA = (size_t)HALF * g.lda * 2, hstepB = (size_t)HALF * g.ldb * 2;
    const size_t tstepA = 2 * hstepA, tstepB = 2 * hstepB;
    const unsigned ldsw = (unsigned)wid * 1024u;
    const int aoff = lds_byte(wr * 64 + fr, fq * 8), boff = lds_byte(wc * 32 + fr, fq * 8);
#define PG8_SA(b, h) (((b) * 2 + (h)) * HTB)
#define PG8_SB(b, h) ((4 + (b) * 2 + (h)) * HTB)
#define PG8_STAGE(bufoff, gbase, voff) do { _Pragma("unroll") for (int _i = 0; _i < 2; ++_i) \
        __builtin_amdgcn_global_load_lds((const unsigned*)((const char*)(gbase) + (voff)[_i]), (PG8_LAS unsigned*)(lds + (bufoff) + ldsw + _i * 8192), 16, 0, 0); } while (0)
#define PG8_LDA(dst, b, h) do { _Pragma("unroll") for (int m = 0; m < 4; ++m) _Pragma("unroll") for (int k = 0; k < 2; ++k) dst[m][k] = *(const PG8_LAS bf16x8*)(lds + PG8_SA(b, h) + aoff + m * 2048 + k * 1024); } while (0)
#define PG8_LDB(dst, b, h) do { _Pragma("unroll") for (int n = 0; n < 2; ++n) _Pragma("unroll") for (int k = 0; k < 2; ++k) dst[n][k] = *(const PG8_LAS bf16x8*)(lds + PG8_SB(b, h) + boff + n * 2048 + k * 1024); } while (0)
#define PG8_MMA(ai, bj, At, Bt) do { __builtin_amdgcn_s_setprio(1); _Pragma("unroll") for (int m = 0; m < 4; ++m) _Pragma("unroll") for (int n = 0; n < 2; ++n) _Pragma("unroll") for (int k = 0; k < 2; ++k) \
        acc[ai][bj][m][n] = __builtin_amdgcn_mfma_f32_16x16x32_bf16(Bt[n][k], At[m][k], acc[ai][bj][m][n], 0, 0, 0); __builtin_amdgcn_s_setprio(0); } while (0)
#define PG8_WAIT_V(n) asm volatile("s_waitcnt vmcnt(" #n ")" ::: "memory")
#define PG8_WAIT_L(n) asm volatile("s_waitcnt lgkmcnt(" #n ")" ::: "memory")
#define PG8_BAR __builtin_amdgcn_s_barrier()
#define PG8_SCHED __builtin_amdgcn_sched_barrier(0)
    Unit cur, nxt; int ui = 0;
    if (!S.next(0, cur)) return;
    f32x4 acc[2][2][4][2];
#pragma unroll
    for (int a = 0; a < 2; ++a)
#pragma unroll
        for (int b = 0; b < 2; ++b)
#pragma unroll
            for (int m = 0; m < 4; ++m)
#pragma unroll
                for (int n = 0; n < 2; ++n) acc[a][b][m][n] = (f32x4){0.f, 0.f, 0.f, 0.f};
    bf16x8 At[4][2], B0[2][2], B1[2][2];
    const char* cA = (const char*)g.A + (size_t)cur.pm * tstepA; const char* cB = (const char*)g.Bt + (size_t)cur.pn * tstepB;
    PG8_STAGE(PG8_SB(0, 0), cB, voffB); PG8_STAGE(PG8_SB(0, 1), cB + hstepB, voffB); PG8_STAGE(PG8_SA(0, 0), cA, voffA); PG8_STAGE(PG8_SA(0, 1), cA + hstepA, voffA);
    if (wr == 1) PG8_BAR;
    PG8_WAIT_V(2); PG8_BAR;
    PG8_STAGE(PG8_SB(1, 0), cB + kstep, voffB); PG8_STAGE(PG8_SA(1, 0), cA + kstep, voffA); PG8_STAGE(PG8_SB(1, 1), cB + hstepB + kstep, voffB);
    PG8_WAIT_V(6); PG8_BAR;
    for (;;) {
        const bool has_next = S.next(ui + 1, nxt);
        const char* nA = has_next ? (const char*)g.A + (size_t)nxt.pm * tstepA : cA; const char* nB = has_next ? (const char*)g.Bt + (size_t)nxt.pn * tstepB : cB;
#pragma unroll 1
        for (int t = 0; t < nt; t += 2) {
            const bool last = (t == nt - 2);
            const char* a1 = cA + (size_t)(t + 1) * kstep;
            const char* a2 = last ? nA : cA + (size_t)(t + 2) * kstep; const char* b2 = last ? nB : cB + (size_t)(t + 2) * kstep;
            const char* a3 = a2 + kstep; const char* b3 = b2 + kstep;
            PG8_LDB(B0, 0, 0); PG8_LDB(B1, 0, 1); PG8_SCHED; PG8_LDA(At, 0, 0); PG8_STAGE(PG8_SA(1, 1), a1 + hstepA, voffA);
            PG8_WAIT_V(8); PG8_WAIT_L(0); PG8_BAR; PG8_MMA(0, 0, At, B0); PG8_MMA(0, 1, At, B1); PG8_BAR; PG8_SCHED;
            PG8_LDA(At, 0, 1); PG8_STAGE(PG8_SB(0, 0), b2, voffB); PG8_STAGE(PG8_SB(0, 1), b2 + hstepB, voffB); PG8_STAGE(PG8_SA(0, 0), a2, voffA);
            PG8_WAIT_V(8); PG8_WAIT_L(0); PG8_BAR; PG8_MMA(1, 0, At, B0); PG8_MMA(1, 1, At, B1); PG8_BAR; PG8_SCHED;
            PG8_LDB(B0, 1, 0); PG8_LDB(B1, 1, 1); PG8_SCHED; PG8_LDA(At, 1, 0); PG8_STAGE(PG8_SA(0, 1), a2 + hstepA, voffA);
            PG8_WAIT_V(8); PG8_WAIT_L(0); PG8_BAR; PG8_MMA(0, 0, At, B0); PG8_MMA(0, 1, At, B1); PG8_BAR; PG8_SCHED;
            PG8_LDA(At, 1, 1); PG8_STAGE(PG8_SB(1, 0), b3, voffB); PG8_STAGE(PG8_SB(1, 1), b3 + hstepB, voffB); PG8_STAGE(PG8_SA(1, 0), a3, voffA);
            PG8_WAIT_V(8); PG8_WAIT_L(0); PG8_BAR; PG8_MMA(1, 0, At, B0); PG8_MMA(1, 1, At, B1); PG8_BAR; PG8_SCHED;
        }
        if (wr == 0) PG8_BAR;
        {
            const int row0 = cur.pm * BM + wr * 64 + fr, col0 = cur.pn * BM + wc * 32 + 4 * fq;
#pragma unroll
            for (int ai = 0; ai < 2; ++ai)
#pragma unroll
                for (int m = 0; m < 4; ++m)
#pragma unroll
                    for (int n = 0; n < 2; ++n) E(row0 + ai * HALF + m * 16, col0 + n * 16, acc[ai][0][m][n], acc[ai][1][m][n]);
        }
        if (!has_next) break;
#pragma unroll
        for (int a = 0; a < 2; ++a)
#pragma unroll
            for (int b = 0; b < 2; ++b)
#pragma unroll
                for (int m = 0; m < 4; ++m)
#pragma unroll
                    for (int n = 0; n < 2; ++n) acc[a][b][m][n] = (f32x4){0.f, 0.f, 0.f, 0.f};
        cur = nxt; cA = nA; cB = nB; ++ui;
        if (wr == 1) PG8_BAR;
    }
    PG8_WAIT_V(0);
    PG8_BAR;
#undef PG8_SA
#undef PG8_SB
#undef PG8_STAGE
#undef PG8_LDA
#undef PG8_LDB
#undef PG8_MMA
#undef PG8_WAIT_V
#undef PG8_WAIT_L
#undef PG8_BAR
#undef PG8_SCHED
}
}
template <class Epi>
DI void gemm_run(unsigned char* lds, const bf16_t* A, int lda, const bf16_t* Bt, int ldb, int Mm, int N, int K, const Epi& E) {
    pg8::Gemm g{A, Bt, Mm, N, K, lda, ldb}; pg8::StaticOrder S; S.init(Mm, N, (int)gridDim.x, (int)blockIdx.x);
    pg8::gemm_phase((PG8_LAS unsigned char*)lds, g, S, E);
}

struct EpiProjA { bf16_t* O; float* AB;
    DI void operator()(int r, int c, f32x4 a, f32x4 b) const { bf16_t* o = O + (size_t)r * NA + c; st4(o, a); st4(o + 128, b);
        if (c >= 3072 && c < 3088) *(f32x4*)(AB + (size_t)r * 16 + (c - 3072)) = a; } };
struct EpiStore { bf16_t* O; int ldo;
    DI void operator()(int r, int c, f32x4 a, f32x4 b) const { bf16_t* o = O + (size_t)r * ldo + c; st4(o, a); st4(o + 128, b); } };
struct EpiQ { bf16_t* O;
    DI void operator()(int r, int c, f32x4 a, f32x4 b) const { bf16_t* o = O + (size_t)r * 1536 + c; st4(o, a * C2); st4(o + 128, b * C2); } };
struct EpiKV { bf16_t* KN; bf16_t* V;
    DI void one(int r, int c, f32x4 v) const { if (c < 1024) st4(KN + (size_t)r * 1024 + c, v); else st4(V + (size_t)r * 1024 + c - 1024, v); }
    DI void operator()(int r, int c, f32x4 a, f32x4 b) const { one(r, c, a); one(r, c + 128, b); } };
struct EpiZG { bf16_t* Z; bf16_t* GD; bf16_t* GM;
    DI void one(int r, int c, f32x4 v) const { bf16_t* o = c < 1024 ? Z + c : (c < 2048 ? GD + (c - 1024) : GM + (c - 2048)); st4(o + (size_t)r * 1024, v); }
    DI void operator()(int r, int c, f32x4 a, f32x4 b) const { one(r, c, a); one(r, c + 128, b); } };
struct EpiYdn { bf16_t* GD;
    DI void one(int r, int c, f32x4 v) const { bf16_t* g = GD + (size_t)r * 1024 + c; const f32x4 gv = ld4(g);
        st4(g, (f32x4){sigm(gv[0]) * v[0], sigm(gv[1]) * v[1], sigm(gv[2]) * v[2], sigm(gv[3]) * v[3]}); }
    DI void operator()(int r, int c, f32x4 a, f32x4 b) const { one(r, c, a); one(r, c + 128, b); } };
struct EpiYmla { const bf16_t* GD; bf16_t* GM;
    DI void one(int r, int c, f32x4 v) const { bf16_t* g = GM + (size_t)r * 1024 + c; const f32x4 gv = ld4(g), tv = ld4(GD + (size_t)r * 1024 + c);
        st4(g, (f32x4){tv[0] + sigm(gv[0]) * v[0], tv[1] + sigm(gv[1]) * v[1], tv[2] + sigm(gv[2]) * v[2], tv[3] + sigm(gv[3]) * v[3]}); }
    DI void operator()(int r, int c, f32x4 a, f32x4 b) const { one(r, c, a); one(r, c + 128, b); } };
struct EpiWo { const float* x; float* T1;
    DI void one(int r, int c, f32x4 v) const { const size_t o = (size_t)r * D + c; *(f32x4*)(T1 + o) = *(const f32x4*)(x + o) * ALPHA + v; }
    DI void operator()(int r, int c, f32x4 a, f32x4 b) const { one(r, c, a); one(r, c + 128, b); } };
struct EpiFfnIn { bf16_t* ACT;
    DI void operator()(int r, int c, f32x4 a, f32x4 b) const { const int t = c >> 8, j = c & 255;
        st4(ACT + (size_t)r * FF + 128 * t + j, (f32x4){silu(a[0]) * b[0], silu(a[1]) * b[1], silu(a[2]) * b[2], silu(a[3]) * b[3]}); } };
struct EpiSg { bf16_t* SG;
    DI void one(int r, int c, f32x4 v) const { st4(SG + (size_t)r * D + c, (f32x4){sigm(v[0]), sigm(v[1]), sigm(v[2]), sigm(v[3])}); }
    DI void operator()(int r, int c, f32x4 a, f32x4 b) const { one(r, c, a); one(r, c + 128, b); } };
struct EpiFfnOut { float* H1; const bf16_t* SG; const bf16_t* PLE0;
    DI void one(int r, int c, f32x4 v) const { const size_t o = (size_t)r * D + c; *(f32x4*)(H1 + o) = *(const f32x4*)(H1 + o) * ALPHA + v + ld4(SG + o) * ld4(PLE0 + o); }
    DI void operator()(int r, int c, f32x4 a, f32x4 b) const { one(r, c, a); one(r, c + 128, b); } };

DI float sum16(float v) { v += __shfl_xor(v, 1); v += __shfl_xor(v, 2); v += __shfl_xor(v, 4); v += __shfl_xor(v, 8); return v; }
DI void unpack8(float* f, u32x4 u) { f[0] = bflo(u.x); f[1] = bfhi(u.x); f[2] = bflo(u.y); f[3] = bfhi(u.y); f[4] = bflo(u.z); f[5] = bfhi(u.z); f[6] = bflo(u.w); f[7] = bfhi(u.w); }
DI void p2_tokens(const Params& P, int gw, int ngw, int lane) {
    unsigned char* ws = P.ws;
    const bf16_t* PA = (const bf16_t*)(ws + O_PROJA); const float* AB = (const float*)(ws + O_AB);
    bf16_t* DQ = (bf16_t*)P.out; bf16_t* DK = DQ + (size_t)M * 1024; bf16_t* DV = (bf16_t*)(ws + O_DV);
    float* BETA = (float*)(ws + O_BETA); float* GG = (float*)(ws + O_GG);
    bf16_t* CQ = (bf16_t*)(ws + O_CQ); bf16_t* CKV = (bf16_t*)(ws + O_CKV); bf16_t* KR = (bf16_t*)(ws + O_KR);
    for (int it = gw; it < 6 * (M / 32); it += ngw) {
        const int seg = it % 6, m0 = (it / 6) * 32;
        const int c0 = seg * 512 + 8 * lane;
        float w[4][8];
#pragma unroll
        for (int i = 0; i < 4; ++i) { const f32x4 a = *(const f32x4*)(P.conv_w + i * 3072 + c0), b = *(const f32x4*)(P.conv_w + i * 3072 + c0 + 4);
            w[i][0] = a[0]; w[i][1] = a[1]; w[i][2] = a[2]; w[i][3] = a[3]; w[i][4] = b[0]; w[i][5] = b[1]; w[i][6] = b[2]; w[i][7] = b[3]; }
        float xw[3][8];
        const bool first = (m0 % S) == 0;
#pragma unroll
        for (int i = 0; i < 3; ++i) { u32x4 u = (u32x4){0u, 0u, 0u, 0u}; if (!first) u = *(const u32x4*)(PA + (size_t)(m0 - 3 + i) * NA + c0); unpack8(xw[i], u); }
        bf16_t* dst = (seg < 2 ? DQ : (seg < 4 ? DK : DV)) + (seg & 1) * 512 + 8 * lane;
        const float qs = seg < 2 ? 0.08838834764831845f : 1.f;
        for (int t = 0; t < 32; t += 4) {
            u32x4 un[4];
#pragma unroll
            for (int q = 0; q < 4; ++q) un[q] = *(const u32x4*)(PA + (size_t)(m0 + t + q) * NA + c0);
#pragma unroll
            for (int q = 0; q < 4; ++q) {
                float xc[8]; unpack8(xc, un[q]);
                float a[8]; float ss = 0.f;
#pragma unroll
                for (int j = 0; j < 8; ++j) { a[j] = silu(w[0][j] * xw[0][j] + w[1][j] * xw[1][j] + w[2][j] * xw[2][j] + w[3][j] * xc[j]); ss += a[j] * a[j]; }
                if (seg < 4) { const float r = rsqrtf(sum16(ss) + 1e-6f) * qs;
#pragma unroll
                    for (int j = 0; j < 8; ++j) a[j] *= r; }
                u32x4 o; o.x = pk2(a[0], a[1]); o.y = pk2(a[2], a[3]); o.z = pk2(a[4], a[5]); o.w = pk2(a[6], a[7]);
                *(u32x4*)(dst + (size_t)(m0 + t + q) * 1024) = o;
#pragma unroll
                for (int j = 0; j < 8; ++j) { xw[0][j] = xw[1][j]; xw[1][j] = xw[2][j]; xw[2][j] = xc[j]; }
            }
        }
    }
    const int sub = lane >> 4, l16 = lane & 15;
    for (int it = gw; it < M / 4; it += ngw) {
        const int m = it * 4 + sub;
        const bf16_t* row = PA + (size_t)m * NA;
        if (l16 < 8) { const float br = AB[(size_t)m * 16 + l16], ar = AB[(size_t)m * 16 + 8 + l16];
            BETA[(size_t)m * 8 + l16] = sigm(br);
            const float xx = ar + P.dt_bias[l16]; const float sp = fmaxf(xx, 0.f) + log1pf(__expf(-fabsf(xx)));
            GG[(size_t)m * 8 + l16] = -__expf(P.a_log[l16]) * sp; }
        {
            float v[3][8]; float ss = 0.f;
#pragma unroll
            for (int j = 0; j < 3; ++j) { unpack8(v[j], *(const u32x4*)(row + 3088 + 8 * (l16 + 16 * j)));
#pragma unroll
                for (int e = 0; e < 8; ++e) ss += v[j][e] * v[j][e]; }
            const float r = rsqrtf(sum16(ss) * (1.f / 384.f) + 1e-6f);
#pragma unroll
            for (int j = 0; j < 3; ++j) { const int idx = 8 * (l16 + 16 * j); const f32x4 wa = *(const f32x4*)(P.q_norm_w + idx), wb = *(const f32x4*)(P.q_norm_w + idx + 4);
                u32x4 o; o.x = pk2(v[j][0] * r * wa[0], v[j][1] * r * wa[1]); o.y = pk2(v[j][2] * r * wa[2], v[j][3] * r * wa[3]); o.z = pk2(v[j][4] * r * wb[0], v[j][5] * r * wb[1]); o.w = pk2(v[j][6] * r * wb[2], v[j][7] * r * wb[3]);
                *(u32x4*)(CQ + (size_t)m * 384 + idx) = o; }
        }
        {
            float v[2][8]; float ss = 0.f;
#pragma unroll
            for (int j = 0; j < 2; ++j) { unpack8(v[j], *(const u32x4*)(row + 3472 + 8 * (l16 + 16 * j)));
#pragma unroll
                for (int e = 0; e < 8; ++e) ss += v[j][e] * v[j][e]; }
            const float r = rsqrtf(sum16(ss) * (1.f / 256.f) + 1e-6f);
#pragma unroll
            for (int j = 0; j < 2; ++j) { const int idx = 8 * (l16 + 16 * j); const f32x4 wa = *(const f32x4*)(P.kv_norm_w + idx), wb = *(const f32x4*)(P.kv_norm_w + idx + 4);
                u32x4 o; o.x = pk2(v[j][0] * r * wa[0], v[j][1] * r * wa[1]); o.y = pk2(v[j][2] * r * wa[2], v[j][3] * r * wa[3]); o.z = pk2(v[j][4] * r * wb[0], v[j][5] * r * wb[1]); o.w = pk2(v[j][6] * r * wb[2], v[j][7] * r * wb[3]);
                *(u32x4*)(CKV + (size_t)m * 256 + idx) = o; }
        }
        {
            const unsigned ua = *(const unsigned*)(row + 3728 + 2 * l16), ub = *(const unsigned*)(row + 3728 + 32 + 2 * l16);
            const int ps = P.pos[m]; float c0_, s0_, c1_, s1_; rope_cs(ps, 2 * l16, c0_, s0_); rope_cs(ps, 2 * l16 + 1, c1_, s1_);
            const float a1 = bflo(ua), a2 = bflo(ub), b1 = bfhi(ua), b2 = bfhi(ub);
            u32x2 o; o.x = pk2(a1 * c0_ - a2 * s0_, a2 * c0_ + a1 * s0_); o.y = pk2(b1 * c1_ - b2 * s1_, b2 * c1_ + b1 * s1_);
            *(u32x2*)(KR + (size_t)m * 64 + 4 * l16) = o;
        }
    }
}

typedef float f32x16 __attribute__((ext_vector_type(16)));
typedef short s16x4 __attribute__((ext_vector_type(4)));
#define LAS __attribute__((address_space(3)))
typedef LAS unsigned char* lptr;
DI s16x4 vtr(lptr p) { return __builtin_bit_cast(s16x4, __builtin_amdgcn_ds_read_tr16_b64_v4i16((LAS s16x4*)p)); }
#define MFMA32(a, b, c) __builtin_amdgcn_mfma_f32_32x32x16_bf16((a), (b), (c), 0, 0, 0)
DI bf16x8 pack8(const f32x16& x, int o) { u32x4 p; p.x = pk2(x[o], x[o + 1]); p.y = pk2(x[o + 2], x[o + 3]); p.z = pk2(x[o + 4], x[o + 5]); p.w = pk2(x[o + 6], x[o + 7]); return __builtin_bit_cast(bf16x8, p); }
DI void attn_unit(const Params& P, unsigned char* lds_, int bh, int qb) {
    lptr lds = (lptr)lds_;
    constexpr int KP = 400, VP = 272, KBUF = 64 * KP, VBUF = 64 * VP;
    unsigned char* ws = P.ws;
    bf16_t* Qg = (bf16_t*)(ws + O_Q); const bf16_t* KN = (const bf16_t*)(ws + O_KN); const bf16_t* V = (const bf16_t*)(ws + O_V); const bf16_t* KR = (const bf16_t*)(ws + O_KR);
    const int tid = threadIdx.x, lane = tid & 63, w = __builtin_amdgcn_readfirstlane(tid >> 6), r32 = lane & 31, hi = lane >> 5;
    const int b = bh >> 3, h = bh & 7;
    const size_t rowb = (size_t)b * S;
    {
        {
            const int q0 = qb * 256, NT = (q0 + 256) / 64;
            const int qrow = q0 + 32 * w + r32;
            bf16x8 qf[12];
            { const bf16_t* qp = Qg + (rowb + qrow) * 1536 + h * 192 + 8 * hi;
#pragma unroll
              for (int ks = 0; ks < 12; ++ks) qf[ks] = *(const bf16x8*)(qp + 16 * ks);
              const int ps = P.pos[rowb + qrow];
#pragma unroll
              for (int ks = 8; ks < 12; ++ks) { u32x4 u = __builtin_bit_cast(u32x4, qf[ks]);
#pragma unroll
                  for (int pj = 0; pj < 4; ++pj) { float c, s; rope_cs(ps, 8 * (ks - 8) + 4 * hi + pj, c, s); const unsigned w = u[pj]; const float t1 = bflo(w), t2 = bfhi(w); u[pj] = pk2(t1 * c - t2 * s, t2 * c + t1 * s); }
                  qf[ks] = __builtin_bit_cast(bf16x8, u); } }
            const bf16_t* kn_src = KN + (rowb + (tid >> 4)) * 1024 + h * 128 + (tid & 15) * 8;
            const bf16_t* kr_src = KR + (rowb + (tid >> 3)) * 64 + (tid & 7) * 8;
            const bf16_t* v_src = V + (rowb + (tid >> 4)) * 1024 + h * 128 + (tid & 15) * 8;
            const int kdst = (tid >> 4) * KP + (tid & 15) * 16, krdst = (tid >> 3) * KP + 256 + (tid & 7) * 16, vdst = (tid >> 4) * VP + (tid & 15) * 16;
            u32x4 st0, st1, st2, st3, st4_;
#define LOADT(kt) do { const size_t o_ = (size_t)(kt) * 64; st0 = *(const u32x4*)(kn_src + o_ * 1024); st1 = *(const u32x4*)(kn_src + (o_ + 32) * 1024); st2 = *(const u32x4*)(kr_src + o_ * 64); \
                       st3 = *(const u32x4*)(v_src + o_ * 1024); st4_ = *(const u32x4*)(v_src + (o_ + 32) * 1024); } while (0)
#define STORET(buf) do { lptr kb_ = lds + (buf) * KBUF; lptr vb_ = lds + 2 * KBUF + (buf) * VBUF; *(LAS u32x4*)(kb_ + kdst) = st0; *(LAS u32x4*)(kb_ + kdst + 32 * KP) = st1; *(LAS u32x4*)(kb_ + krdst) = st2; \
                         *(LAS u32x4*)(vb_ + vdst) = st3; *(LAS u32x4*)(vb_ + vdst + 32 * VP) = st4_; } while (0)
            __syncthreads();
            LOADT(0); STORET(0);
            __syncthreads();
            f32x16 o[4];
#pragma unroll
            for (int d = 0; d < 4; ++d)
#pragma unroll
                for (int i = 0; i < 16; ++i) o[d][i] = 0.f;
            float m_run = -1e30f, l_run = 0.f;
            for (int kt = 0; kt < NT; ++kt) {
                const int buf = kt & 1;
                if (kt + 1 < NT) LOADT(kt + 1);
                if (64 * kt <= q0 + 32 * w + 31) {
                    lptr kb = lds + buf * KBUF + r32 * KP + hi * 16;
                    f32x16 s0, s1;
#pragma unroll
                    for (int i = 0; i < 16; ++i) { s0[i] = 0.f; s1[i] = 0.f; }
#pragma unroll
                    for (int ks = 0; ks < 12; ++ks) { const bf16x8 a0 = *(const LAS bf16x8*)(kb + ks * 32), a1 = *(const LAS bf16x8*)(kb + 32 * KP + ks * 32);
                        s0 = MFMA32(a0, qf[ks], s0); s1 = MFMA32(a1, qf[ks], s1); }
                    if (64 * kt + 63 > q0 + 32 * w) {
                        const int kv0 = 64 * kt + 4 * hi;
#pragma unroll
                        for (int i = 0; i < 16; ++i) { const int kv = kv0 + (i & 3) + 8 * (i >> 2); if (kv > qrow) s0[i] = -1e30f; if (kv + 32 > qrow) s1[i] = -1e30f; }
                    }
                    float mx = fmaxf(s0[0], s1[0]);
#pragma unroll
                    for (int i = 1; i < 16; ++i) mx = fmaxf(mx, fmaxf(s0[i], s1[i]));
                    mx = fmaxf(mx, __shfl_xor(mx, 32));
                    const float m_new = fmaxf(m_run, mx), al = __builtin_amdgcn_exp2f(m_run - m_new); m_run = m_new;
                    float ps = 0.f;
#pragma unroll
                    for (int i = 0; i < 16; ++i) { s0[i] = __builtin_amdgcn_exp2f(s0[i] - m_new); s1[i] = __builtin_amdgcn_exp2f(s1[i] - m_new); ps += s0[i] + s1[i]; }
                    l_run = l_run * al + ps;
#pragma unroll
                    for (int d = 0; d < 4; ++d) o[d] = o[d] * al;
                    bf16x8 pf[4]; pf[0] = pack8(s0, 0); pf[1] = pack8(s0, 8); pf[2] = pack8(s1, 0); pf[3] = pack8(s1, 8);
                    lptr vb = lds + 2 * KBUF + buf * VBUF + (4 * hi + ((lane & 15) >> 2)) * VP + (((lane >> 4) & 1) * 16 + (lane & 3) * 4) * 2;
#pragma unroll
                    for (int s = 0; s < 4; ++s)
#pragma unroll
                        for (int d = 0; d < 4; ++d) { const s16x4 lo = vtr(vb + s * 16 * VP + d * 64), hh = vtr(vb + (s * 16 + 8) * VP + d * 64);
                            const bf16x8 a = __builtin_shufflevector(lo, hh, 0, 1, 2, 3, 4, 5, 6, 7); o[d] = MFMA32(a, pf[s], o[d]); }
                }
                if (kt + 1 < NT) STORET(buf ^ 1);
                __syncthreads();
            }
#undef LOADT
#undef STORET
            l_run += __shfl_xor(l_run, 32);
            const float il = 1.f / l_run;
            bf16_t* op = Qg + (rowb + qrow) * 1536 + h * 192 + 4 * hi;
#pragma unroll
            for (int d = 0; d < 4; ++d)
#pragma unroll
                for (int g = 0; g < 4; ++g) st4(op + 32 * d + 8 * g, (f32x4){o[d][4 * g], o[d][4 * g + 1], o[d][4 * g + 2], o[d][4 * g + 3]} * il);
        }
    }
}

DI void attn_queue(const Params& P, unsigned char* lds_, unsigned* qcnt) {
    LAS int* slot = (LAS int*)((lptr)lds_ + 147392);
    const int myx = blockIdx.x & 7;
    for (int qq = 0; qq < 8; ++qq) {
        const int x = (myx + qq) & 7;
        for (;;) {
            __syncthreads();
            if (threadIdx.x == 0) *slot = (int)__hip_atomic_fetch_add(qcnt + 64 * x, 1u, __ATOMIC_RELAXED, __HIP_MEMORY_SCOPE_AGENT);
            __syncthreads();
            const int k = *slot;
            if (k >= 64) break;
            attn_unit(P, lds_, 4 * x + (k & 3), 15 - (k >> 2));
        }
    }
}

#define LFENCE() asm volatile("s_waitcnt lgkmcnt(0)" ::: "memory")
DI int crow(int r, int hi) { return (r & 3) + 8 * (r >> 2) + 4 * hi; }
DI unsigned char* rawp(unsigned char* basep, size_t m0, int h, int o) { return basep + (m0 + (size_t)(o >> 8)) * 2048 + h * 256 + (o & 255); }
DI void store_raw(unsigned char* p, const f32x16& x) { *(u32x4*)p = __builtin_bit_cast(u32x4, pack8(x, 0)); *(u32x4*)(p + 16) = __builtin_bit_cast(u32x4, pack8(x, 8)); }
DI void delta_A(const Params& P, unsigned char* lds_, int gw, int ngw, int lane, int wid) {
    unsigned char* ws = P.ws;
    lptr base = (lptr)lds_ + wid * 18432;
    LAS float* Lm = (LAS float*)base;
    LAS float* gc = (LAS float*)(base + 17408); LAS float* bu = gc + 64; LAS float* bw = bu + 64; LAS float* tl = bw + 64;
    bf16_t* DQ = (bf16_t*)P.out; const bf16_t* DK = DQ + (size_t)M * 1024; const bf16_t* DV = (const bf16_t*)(ws + O_DV);
    const float* BETA = (const float*)(ws + O_BETA); const float* GG = (const float*)(ws + O_GG); float* EGL = (float*)(ws + O_EGL);
    for (int ch = gw; ch < 2048; ch += ngw) {
        asm volatile("" : "+v"(lane));
        const int r32 = lane & 31, hi = lane >> 5;
        const int h = ch & 7, bn = ch >> 3, b = bn >> 6, n = bn & 63; const size_t m0 = (size_t)b * S + 64 * n;
        LFENCE();
        {
            float g = GG[(m0 + lane) * 8 + h]; const float be = BETA[(m0 + lane) * 8 + h];
#pragma unroll
            for (int o = 1; o < 64; o <<= 1) { const float t = __shfl_up(g, o); if (lane >= o) g += t; }
            const float gl = __shfl(g, 63);
            gc[lane] = g; bu[lane] = be; bw[lane] = -be * __expf(g); tl[lane] = __expf(gl - g);
            if (lane == 0) EGL[ch] = __expf(gl);
        }
        LFENCE();
        {
#pragma unroll
            for (int t = 0; t < 3; ++t) { const int ib = t == 0 ? 0 : 1, jb = t == 2 ? 1 : 0;
                asm volatile("" ::: "memory");
                f32x16 x;
#pragma unroll
                for (int i = 0; i < 16; ++i) x[i] = 0.f;
#pragma unroll
                for (int ks = 0; ks < 8; ++ks) { const bf16x8 ka = *(const bf16x8*)(DK + (m0 + 32 * ib + r32) * 1024 + h * 128 + 16 * ks + 8 * hi), kb = *(const bf16x8*)(DK + (m0 + 32 * jb + r32) * 1024 + h * 128 + 16 * ks + 8 * hi);
                    x = MFMA32(ka, kb, x); }
                const int j = 32 * jb + r32; const float gcj = gc[j];
#pragma unroll
                for (int r = 0; r < 16; ++r) { const int i = 32 * ib + crow(r, hi); Lm[i * 68 + j] = (j < i) ? bu[i] * x[r] * __expf(gc[i] - gcj) : 0.f; }
            }
#pragma unroll
            for (int r = 0; r < 16; ++r) Lm[crow(r, hi) * 68 + 32 + r32] = 0.f;
#pragma unroll
            for (int t = 0; t < 3; ++t) { const int jb = t == 2 ? 1 : 0, ib = t == 0 ? 0 : 1;
                asm volatile("" ::: "memory");
                f32x16 x;
#pragma unroll
                for (int q = 0; q < 16; ++q) x[q] = 0.f;
#pragma unroll
                for (int ks = 0; ks < 8; ++ks) { const bf16x8 ka = *(const bf16x8*)(DK + (m0 + 32 * jb + r32) * 1024 + h * 128 + 16 * ks + 8 * hi), qb = *(const bf16x8*)(DQ + (m0 + 32 * ib + r32) * 1024 + h * 128 + 16 * ks + 8 * hi);
                    x = MFMA32(ka, qb, x); }
                const int i = 32 * ib + r32; const float gci = gc[i];
#pragma unroll
                for (int r = 0; r < 16; ++r) { const int j = 32 * jb + crow(r, hi); x[r] = (j <= i) ? x[r] * __expf(gci - gc[j]) : 0.f; }
                store_raw(ws + O_INTRA + (size_t)ch * 6144 + t * 2048 + lane * 32, x);
            }
        }
        LFENCE();
        {
            Lm[lane] = (lane == 0) ? 1.f : 0.f;
            for (int i = 1; i < 64; ++i) {
                float acc = 0.f;
                for (int j = 0; j < i; j += 4) { const f32x4 l4 = *(const LAS f32x4*)(Lm + i * 68 + j);
                    acc += l4[0] * Lm[j * 68 + lane] + l4[1] * Lm[(j + 1) * 68 + lane] + l4[2] * Lm[(j + 2) * 68 + lane] + l4[3] * Lm[(j + 3) * 68 + lane]; }
                LFENCE();
                Lm[i * 68 + lane] = ((lane == i) ? 1.f : 0.f) - acc;
            }
        }
        LFENCE();
        bf16x8 Tu[6], Tw[6];
#pragma unroll
        for (int q = 0; q < 6; ++q) { const int ib = q < 2 ? 0 : 1, s = q < 2 ? q : q - 2; const int i = 32 * ib + r32;
            const LAS float* tp = Lm + i * 68 + 16 * s + 8 * hi; const f32x4 t0 = *(const LAS f32x4*)tp, t1 = *(const LAS f32x4*)(tp + 4);
            const f32x4 u0 = *(const LAS f32x4*)(bu + 16 * s + 8 * hi), u1 = *(const LAS f32x4*)(bu + 16 * s + 8 * hi + 4);
            const f32x4 w0 = *(const LAS f32x4*)(bw + 16 * s + 8 * hi), w1 = *(const LAS f32x4*)(bw + 16 * s + 8 * hi + 4);
            const f32x4 a0 = t0 * u0, a1 = t1 * u1, c0 = t0 * w0, c1 = t1 * w1;
            u32x4 pu, pw; pu.x = pk2(a0[0], a0[1]); pu.y = pk2(a0[2], a0[3]); pu.z = pk2(a1[0], a1[1]); pu.w = pk2(a1[2], a1[3]);
            pw.x = pk2(c0[0], c0[1]); pw.y = pk2(c0[2], c0[3]); pw.z = pk2(c1[0], c1[1]); pw.w = pk2(c1[2], c1[3]);
            Tu[q] = __builtin_bit_cast(bf16x8, pu); Tw[q] = __builtin_bit_cast(bf16x8, pw); }
        const float tli = tl[r32], tli1 = tl[32 + r32], eg0 = __expf(gc[r32]), eg1 = __expf(gc[32 + r32]);
        LFENCE();
#pragma unroll 4
        for (int it = 0; it < 16; ++it) { const int idx = it * 64 + lane, row = idx >> 4, c16 = idx & 15;
            *(LAS u32x4*)(base + row * 272 + c16 * 16) = *(const u32x4*)(DV + (m0 + row) * 1024 + h * 128 + c16 * 8); }
        LFENCE();
        lptr vb = base + (8 * hi + ((lane & 15) >> 2)) * 272 + (((lane >> 4) & 1) * 16 + (lane & 3) * 4) * 2;
#pragma unroll 1
        for (int eb = 0; eb < 4; ++eb) {
            bf16x8 vf[4];
#pragma unroll
            for (int s = 0; s < 4; ++s) { const s16x4 lo = vtr(vb + 16 * s * 272 + eb * 64), hh = vtr(vb + (16 * s + 4) * 272 + eb * 64); vf[s] = __builtin_shufflevector(lo, hh, 0, 1, 2, 3, 4, 5, 6, 7); }
#pragma unroll
            for (int ib = 0; ib < 2; ++ib) { f32x16 x;
#pragma unroll
                for (int i = 0; i < 16; ++i) x[i] = 0.f;
#pragma unroll
                for (int s = 0; s < 4; ++s) if (ib == 1 || s < 2) x = MFMA32(Tu[ib == 0 ? s : 2 + s], vf[s], x);
                store_raw(rawp(ws + O_DV, m0, h, (eb * 2 + ib) * 2048 + lane * 32), x); }
        }
        LFENCE();
#pragma unroll 4
        for (int it = 0; it < 16; ++it) { const int idx = it * 64 + lane, row = idx >> 4, c16 = idx & 15;
            *(LAS u32x4*)(base + row * 272 + c16 * 16) = *(const u32x4*)(DK + (m0 + row) * 1024 + h * 128 + c16 * 8); }
        LFENCE();
#pragma unroll 1
        for (int dkb = 0; dkb < 4; ++dkb) {
            bf16x8 kf[4];
#pragma unroll
            for (int s = 0; s < 4; ++s) { const s16x4 lo = vtr(vb + 16 * s * 272 + dkb * 64), hh = vtr(vb + (16 * s + 4) * 272 + dkb * 64); kf[s] = __builtin_shufflevector(lo, hh, 0, 1, 2, 3, 4, 5, 6, 7); }
#pragma unroll
            for (int ib = 0; ib < 2; ++ib) { f32x16 x;
#pragma unroll
                for (int i = 0; i < 16; ++i) x[i] = 0.f;
#pragma unroll
                for (int s = 0; s < 4; ++s) if (ib == 1 || s < 2) x = MFMA32(kf[s], Tw[ib == 0 ? s : 2 + s], x);
                store_raw(ws + O_WT + (size_t)ch * 16384 + (dkb * 2 + ib) * 2048 + lane * 32, x); }
#pragma unroll
            for (int ib = 0; ib < 2; ++ib) { f32x16 x;
#pragma unroll
                for (int i = 0; i < 16; ++i) x[i] = 0.f;
                const unsigned tb = f2bf(ib ? tli1 : tli);
#pragma unroll
                for (int t = 0; t < 2; ++t) { const int rel = r32 - 16 * t - 8 * hi;
                    u32x4 d; d.x = (rel == 0 ? tb : 0u) | (rel == 1 ? tb << 16 : 0u); d.y = (rel == 2 ? tb : 0u) | (rel == 3 ? tb << 16 : 0u);
                    d.z = (rel == 4 ? tb : 0u) | (rel == 5 ? tb << 16 : 0u); d.w = (rel == 6 ? tb : 0u) | (rel == 7 ? tb << 16 : 0u);
                    x = MFMA32(__builtin_bit_cast(bf16x8, d), kf[2 * ib + t], x); }
                store_raw(rawp((unsigned char*)DQ + (size_t)M * 2048, m0, h, (ib * 4 + dkb) * 2048 + lane * 32), x); }
        }
        LFENCE();
#pragma unroll 4
        for (int it = 0; it < 16; ++it) { const int idx = it * 64 + lane, row = idx >> 4, c16 = idx & 15;
            *(LAS u32x4*)(base + row * 272 + c16 * 16) = *(const u32x4*)(DQ + (m0 + row) * 1024 + h * 128 + c16 * 8); }
        asm volatile("s_waitcnt vmcnt(0) lgkmcnt(0)" ::: "memory");
#pragma unroll
        for (int blk = 0; blk < 8; ++blk) { const int dkb = blk >> 1, ib = blk & 1; const float e = ib ? eg1 : eg0;
            lptr qp = base + (32 * ib + r32) * 272 + (32 * dkb + 4 * hi) * 2;
            u32x2 q0 = *(const LAS u32x2*)qp, q1 = *(const LAS u32x2*)(qp + 16), q2 = *(const LAS u32x2*)(qp + 32), q3 = *(const LAS u32x2*)(qp + 48);
            u32x4 lo, hh;
            lo.x = pk2(bflo(q0.x) * e, bfhi(q0.x) * e); lo.y = pk2(bflo(q0.y) * e, bfhi(q0.y) * e); lo.z = pk2(bflo(q1.x) * e, bfhi(q1.x) * e); lo.w = pk2(bflo(q1.y) * e, bfhi(q1.y) * e);
            hh.x = pk2(bflo(q2.x) * e, bfhi(q2.x) * e); hh.y = pk2(bflo(q2.y) * e, bfhi(q2.y) * e); hh.z = pk2(bflo(q3.x) * e, bfhi(q3.x) * e); hh.w = pk2(bflo(q3.y) * e, bfhi(q3.y) * e);
            const int o = blk * 2048 + lane * 32;
            unsigned char* dst = (unsigned char*)DQ + (m0 + (o >> 8)) * 2048 + h * 256 + (o & 255);
            *(u32x4*)dst = lo; *(u32x4*)(dst + 16) = hh; }
    }
}
DI void unpack16(f32x16& x, const unsigned char* p) { const u32x4 a = *(const u32x4*)p, b = *(const u32x4*)(p + 16);
    x[0] = bflo(a.x); x[1] = bfhi(a.x); x[2] = bflo(a.y); x[3] = bfhi(a.y); x[4] = bflo(a.z); x[5] = bfhi(a.z); x[6] = bflo(a.w); x[7] = bfhi(a.w);
    x[8] = bflo(b.x); x[9] = bfhi(b.x); x[10] = bflo(b.y); x[11] = bfhi(b.y); x[12] = bflo(b.z); x[13] = bfhi(b.z); x[14] = bflo(b.w); x[15] = bfhi(b.w); }
DI void delta_B2(const Params& P, unsigned char* lds_, int bh) {
    lptr lds = (lptr)lds_;
    constexpr int BUF = 55296;
    unsigned char* ws = P.ws;
    const int tid = threadIdx.x, lane = tid & 63, wid = __builtin_amdgcn_readfirstlane(tid >> 6);
    const int b = bh >> 3, h = bh & 7;
    unsigned char* dq = (unsigned char*)P.out; unsigned char* dk = dq + (size_t)M * 2048; unsigned char* dv = ws + O_DV;
    __syncthreads();
    if (wid >= 4) {
        const int tl = tid - 256;
        u32x4 ra[14], rb[14];
#define DB_LD(n, r) do { const int ch_ = (b * 64 + (n)) * 8 + h; const size_t m0_ = (size_t)b * S + 64 * (n); \
        _Pragma("unroll") for (int j = 0; j < 14; ++j) { const int idx = tl + 256 * j; if (j < 13 || tl < 128) { const unsigned char* s_; \
            if (j < 4) s_ = ws + O_WT + (size_t)ch_ * 16384 + idx * 16; \
            else if (j < 8) s_ = rawp(dq, m0_, h, (idx - 1024) * 16); \
            else if (j < 12) s_ = rawp(dk, m0_, h, (idx - 2048) * 16); \
            else s_ = ws + O_INTRA + (size_t)ch_ * 6144 + (idx - 3072) * 16; \
            r[j] = *(const u32x4*)s_; } } } while (0)
#define DB_ST(bufi, r) do { _Pragma("unroll") for (int j = 0; j < 14; ++j) { const int idx = tl + 256 * j; if (j < 13 || tl < 128) *(LAS u32x4*)(lds + (bufi) * BUF + idx * 16) = r[j]; } } while (0)
        DB_LD(0, ra); DB_LD(1, rb); DB_ST(0, ra); DB_LD(2, ra);
        __syncthreads();
        for (int n = 0; n < 64; n += 2) {
            DB_ST(1, rb); if (n + 3 < 64) DB_LD(n + 3, rb);
            __syncthreads();
            if (n + 2 < 64) { DB_ST(0, ra); if (n + 4 < 64) DB_LD(n + 4, ra); }
            __syncthreads();
        }
#undef DB_LD
#undef DB_ST
    } else {
        const int eb = wid;
        const float* EGL = (const float*)(ws + O_EGL);
        f32x16 St[4];
#pragma unroll
        for (int d = 0; d < 4; ++d)
#pragma unroll
            for (int i = 0; i < 16; ++i) St[d][i] = 0.f;
        u32x4 up[4];
        { unsigned char* u0 = rawp(dv, (size_t)b * S, h, (eb * 2) * 2048 + lane * 32), *u1 = rawp(dv, (size_t)b * S, h, (eb * 2 + 1) * 2048 + lane * 32);
          up[0] = *(const u32x4*)u0; up[1] = *(const u32x4*)(u0 + 16); up[2] = *(const u32x4*)u1; up[3] = *(const u32x4*)(u1 + 16); }
        __syncthreads();
        for (int n = 0; n < 64; ++n) {
            const int ch = (b * 64 + n) * 8 + h; const size_t m0 = (size_t)b * S + 64 * n;
            lptr bf = lds + (n & 1) * BUF + lane * 32;
            const float eg = EGL[ch];
            f32x16 vn[2], ob[2];
#pragma unroll
            for (int ib = 0; ib < 2; ++ib) { const u32x4 a = up[2 * ib], c = up[2 * ib + 1];
                vn[ib][0] = bflo(a.x); vn[ib][1] = bfhi(a.x); vn[ib][2] = bflo(a.y); vn[ib][3] = bfhi(a.y); vn[ib][4] = bflo(a.z); vn[ib][5] = bfhi(a.z); vn[ib][6] = bflo(a.w); vn[ib][7] = bfhi(a.w);
                vn[ib][8] = bflo(c.x); vn[ib][9] = bfhi(c.x); vn[ib][10] = bflo(c.y); vn[ib][11] = bfhi(c.y); vn[ib][12] = bflo(c.z); vn[ib][13] = bfhi(c.z); vn[ib][14] = bflo(c.w); vn[ib][15] = bfhi(c.w); }
            unsigned char* o0 = rawp(dv, m0, h, (eb * 2) * 2048 + lane * 32); unsigned char* o1 = rawp(dv, m0, h, (eb * 2 + 1) * 2048 + lane * 32);
            if (n + 1 < 64) { const unsigned char* u0 = rawp(dv, m0 + 64, h, (eb * 2) * 2048 + lane * 32); const unsigned char* u1 = rawp(dv, m0 + 64, h, (eb * 2 + 1) * 2048 + lane * 32);
                up[0] = *(const u32x4*)u0; up[1] = *(const u32x4*)(u0 + 16); up[2] = *(const u32x4*)u1; up[3] = *(const u32x4*)(u1 + 16); }
            bf16x8 Spk[8];
#pragma unroll
            for (int s = 0; s < 8; ++s) Spk[s] = pack8(St[s >> 1], 8 * (s & 1));
#pragma unroll
            for (int i = 0; i < 16; ++i) { ob[0][i] = 0.f; ob[1][i] = 0.f; }
#pragma unroll
            for (int s = 0; s < 8; ++s)
#pragma unroll
                for (int ib = 0; ib < 2; ++ib) { const int o = ((s >> 1) * 2 + ib) * 2048 + 16 * (s & 1);
                    vn[ib] = MFMA32(*(const LAS bf16x8*)(bf + o), Spk[s], vn[ib]);
                    ob[ib] = MFMA32(*(const LAS bf16x8*)(bf + 16384 + o), Spk[s], ob[ib]); }
            bf16x8 vpk[2][2];
#pragma unroll
            for (int ib = 0; ib < 2; ++ib) { vpk[ib][0] = pack8(vn[ib], 0); vpk[ib][1] = pack8(vn[ib], 8); }
#pragma unroll
            for (int t = 0; t < 2; ++t) {
                ob[0] = MFMA32(*(const LAS bf16x8*)(bf + 49152 + 0 * 2048 + 16 * t), vpk[0][t], ob[0]);
                ob[1] = MFMA32(*(const LAS bf16x8*)(bf + 49152 + 1 * 2048 + 16 * t), vpk[0][t], ob[1]);
                ob[1] = MFMA32(*(const LAS bf16x8*)(bf + 49152 + 2 * 2048 + 16 * t), vpk[1][t], ob[1]);
            }
            store_raw(o0, ob[0]); store_raw(o1, ob[1]);
#pragma unroll
            for (int dkb = 0; dkb < 4; ++dkb) { St[dkb] = St[dkb] * eg;
#pragma unroll
                for (int s = 0; s < 4; ++s) St[dkb] = MFMA32(*(const LAS bf16x8*)(bf + 32768 + ((s >> 1) * 4 + dkb) * 2048 + 16 * (s & 1)), vpk[s >> 1][s & 1], St[dkb]); }
            __syncthreads();
        }
    }
    __syncthreads();
}

DI void p9_normgate(const Params& P, int gw, int ngw, int lane) {
    unsigned char* ws = P.ws;
    const bf16_t* Z = (const bf16_t*)(ws + O_Z); bf16_t* OG = (bf16_t*)P.out + (size_t)M * 1024;
    const int r32 = lane & 31, hi = lane >> 5;
    for (int ch = gw; ch < 2048; ch += ngw) {
        const int h = ch & 7, bn = ch >> 3, b = bn >> 6, n = bn & 63; const size_t m0 = (size_t)b * S + 64 * n;
#pragma unroll 1
        for (int ib = 0; ib < 2; ++ib) {
            f32x16 o[4]; float ss[16];
#pragma unroll
            for (int eb = 0; eb < 4; ++eb) unpack16(o[eb], rawp(ws + O_DV, m0, h, (eb * 2 + ib) * 2048 + lane * 32));
#pragma unroll
            for (int r = 0; r < 16; ++r) { float s = o[0][r] * o[0][r] + o[1][r] * o[1][r] + o[2][r] * o[2][r] + o[3][r] * o[3][r];
                s += __shfl_xor(s, 1); s += __shfl_xor(s, 2); s += __shfl_xor(s, 4); s += __shfl_xor(s, 8); s += __shfl_xor(s, 16);
                ss[r] = rsqrtf(s * (1.f / 128.f) + 1e-6f); }
            const size_t rb_ = (m0 + 32 * ib + 4 * hi) * 1024 + h * 128 + r32;
#pragma unroll
            for (int eb = 0; eb < 4; ++eb) { const float w = P.dn_norm_w[32 * eb + r32];
                const bf16_t* zp = Z + rb_ + 32 * eb; bf16_t* op = OG + rb_ + 32 * eb;
#pragma unroll
                for (int g = 0; g < 4; ++g) {
#pragma unroll
                    for (int q = 0; q < 4; ++q) { const int r = 4 * g + q; op[(8 * g + q) * 1024] = (bf16_t)f2bf(o[eb][r] * ss[r] * w * silu(bf2f(zp[(8 * g + q) * 1024]))); }
                    asm volatile("" ::: "memory");
                } }
        }
    }
}
DI void ln_rows(const float* __restrict__ in, float* __restrict__ outf, bf16_t* __restrict__ outb, const float* g, const float* bta, int gw, int ngw, int lane) {
    for (int m = gw; m < M; m += ngw) {
        const f32x4* xr = (const f32x4*)(in + (size_t)m * D) + lane;
        f32x4 v[4]; float s = 0.f;
#pragma unroll
        for (int j = 0; j < 4; ++j) { v[j] = xr[64 * j]; s += (v[j][0] + v[j][1]) + (v[j][2] + v[j][3]); }
        const float mean = wave_sum(s) * (1.f / D); float s2 = 0.f;
#pragma unroll
        for (int j = 0; j < 4; ++j) { v[j] = v[j] - mean; s2 += (v[j][0] * v[j][0] + v[j][1] * v[j][1]) + (v[j][2] * v[j][2] + v[j][3] * v[j][3]); }
        const float rstd = rsqrtf(wave_sum(s2) * (1.f / D) + 1e-5f);
#pragma unroll
        for (int j = 0; j < 4; ++j) { const int c = 4 * lane + 256 * j; const f32x4 gg = *(const f32x4*)(g + c), bb = *(const f32x4*)(bta + c); const f32x4 o = v[j] * rstd * gg + bb;
            *(f32x4*)(outf + (size_t)m * D + c) = o; if (outb) st4(outb + (size_t)m * D + c, o); }
    }
}

DI void grid_barrier(unsigned* cnt, unsigned& k, unsigned G) {
    asm volatile("s_waitcnt vmcnt(0) lgkmcnt(0)" ::: "memory");
    __syncthreads();
    if (threadIdx.x == 0) {
        __builtin_amdgcn_fence(__ATOMIC_RELEASE, "agent");
        asm volatile("s_waitcnt vmcnt(0)" ::: "memory");
        __hip_atomic_fetch_add(cnt, 1u, __ATOMIC_RELAXED, __HIP_MEMORY_SCOPE_AGENT);
        const unsigned target = (k + 1u) * G;
        while (__hip_atomic_load(cnt, __ATOMIC_RELAXED, __HIP_MEMORY_SCOPE_AGENT) < target) __builtin_amdgcn_s_sleep(1);
        __builtin_amdgcn_fence(__ATOMIC_ACQUIRE, "agent");
        asm volatile("s_waitcnt vmcnt(0)" ::: "memory");
    }
    ++k;
    __syncthreads();
}

constexpr int NPH = 13;
__global__ void __launch_bounds__(NTHREADS, 2) mega(Params P) {
    extern __shared__ __attribute__((aligned(16))) unsigned char lds[];
    cg::grid_group grid = cg::this_grid();
    const int tid = threadIdx.x, lane = tid & 63, wid = tid >> 6;
    const int gw = blockIdx.x * NWAVES + wid, ngw = gridDim.x * NWAVES;
    const size_t gt = (size_t)blockIdx.x * NTHREADS + tid, ngt = (size_t)gridDim.x * NTHREADS;
    unsigned char* ws = P.ws;
    bf16_t* WIN = (bf16_t*)(ws + W_IN);
    bf16_t* XB = (bf16_t*)P.out;
    unsigned* barcnt = (unsigned*)(ws + O_BAR); unsigned bark = 0;
#define PH_BEGIN(k) if (P.ph_lo <= (k) && (k) < P.ph_hi) {
#define PH_END(k) if ((k) + 1 < P.ph_hi) { if ((k) == 0) grid.sync(); else grid_barrier(barcnt, bark, gridDim.x); } }
    PH_BEGIN(0) {
            transpose_mat(P.w_in, 1024, 6864, WIN, NIN, 1, gw, ngw, lane);
            transpose_mat(P.w_uq, 384, 1536, (bf16_t*)(ws + W_UQ), 1536, 4, gw, ngw, lane);
            transpose_mat(P.w_uk, 256, 1024, (bf16_t*)(ws + W_UKV), 1024, 0, gw, ngw, lane);
            transpose_mat(P.w_uv, 256, 1024, (bf16_t*)(ws + W_UKV) + (size_t)1024 * 256, 1024, 0, gw, ngw, lane);
            transpose_mat(P.w_br_dn, 1024, 1024, (bf16_t*)(ws + W_BRDN), 1024, 0, gw, ngw, lane);
            transpose_mat(P.w_br_mla, 1536, 1024, (bf16_t*)(ws + W_BRMLA), 1024, 5, gw, ngw, lane);
            transpose_mat(P.w_o, 1024, 1024, (bf16_t*)(ws + W_O), 1024, 0, gw, ngw, lane);
            transpose_mat(P.w_ffn_in, 1024, 5632, (bf16_t*)(ws + W_FFNIN), 5632, 3, gw, ngw, lane);
            transpose_mat(P.w_ffn_out, FF, 1024, (bf16_t*)(ws + W_FFNOUT), 1024, 0, gw, ngw, lane);
            transpose_mat(P.w_ple_gate, 1024, 1024, (bf16_t*)(ws + W_PG), 1024, 0, gw, ngw, lane);
            transpose_mat(P.w_ple, 256, 1024, (bf16_t*)(ws + W_PLE), 1024, 0, gw, ngw, lane);
            cvt_rows(P.x, XB, (size_t)M * D / 8, gt, ngt);
        } PH_END(0)
    PH_BEGIN(1) { EpiProjA E{(bf16_t*)(ws + O_PROJA), (float*)(ws + O_AB)}; gemm_run(lds, XB, 1024, WIN, 1024, M, NA, 1024, E); } PH_END(1)
    PH_BEGIN(2) p2_tokens(P, gw, ngw, lane); PH_END(2)
    PH_BEGIN(3) { delta_A(P, lds, gw, ngw, lane, wid);
                  __syncthreads();
                  { EpiQ E{(bf16_t*)(ws + O_Q)}; gemm_run(lds, (const bf16_t*)(ws + O_CQ), 384, (const bf16_t*)(ws + W_UQ), 384, M, 1536, 384, E); }
                  { EpiKV E{(bf16_t*)(ws + O_KN), (bf16_t*)(ws + O_V)}; gemm_run(lds, (const bf16_t*)(ws + O_CKV), 256, (const bf16_t*)(ws + W_UKV), 256, M, 2048, 256, E); } } PH_END(3)
    PH_BEGIN(4) {
        unsigned* ctl = (unsigned*)(ws + O_BAR);
        if (blockIdx.x < 32) { for (int u = blockIdx.x; u < 32; u += gridDim.x) delta_B2(P, lds, u);
            if (tid == 0) { asm volatile("s_waitcnt vmcnt(0)" ::: "memory"); __hip_atomic_fetch_add(ctl + 64 * 9, gridDim.x < 32 ? 32u / gridDim.x : 1u, __ATOMIC_RELEASE, __HIP_MEMORY_SCOPE_AGENT); } }
        attn_queue(P, lds, ctl + 64);
        if (tid == 0) { const unsigned want = gridDim.x < 32 ? (32u / gridDim.x) * gridDim.x : 32u; while (__hip_atomic_load(ctl + 64 * 9, __ATOMIC_RELAXED, __HIP_MEMORY_SCOPE_AGENT) < want) __builtin_amdgcn_s_sleep(2); }
        __syncthreads();
        cvt_rows(P.x, XB, (size_t)M * D / 8, gt, ngt);
    } PH_END(4)
    PH_BEGIN(5) { EpiZG E{(bf16_t*)(ws + O_Z), (bf16_t*)(ws + O_GD), (bf16_t*)(ws + O_GM)}; gemm_run(lds, XB, 1024, WIN + (size_t)NA * 1024, 1024, M, NB, 1024, E); } PH_END(5)
    PH_BEGIN(6) p9_normgate(P, gw, ngw, lane); PH_END(6)
    PH_BEGIN(7) { { EpiYdn E{(bf16_t*)(ws + O_GD)}; gemm_run(lds, (const bf16_t*)P.out + (size_t)M * 1024, 1024, (const bf16_t*)(ws + W_BRDN), 1024, M, 1024, 1024, E); }
                  asm volatile("s_waitcnt vmcnt(0)" ::: "memory");
                  { EpiYmla E{(const bf16_t*)(ws + O_GD), (bf16_t*)(ws + O_GM)}; gemm_run(lds, (const bf16_t*)(ws + O_Q), 1536, (const bf16_t*)(ws + W_BRMLA), 1536, M, 1024, 1536, E); } } PH_END(7)
    PH_BEGIN(8) { EpiWo E{P.x, P.out}; gemm_run(lds, (const bf16_t*)(ws + O_GM), 1024, (const bf16_t*)(ws + W_O), 1024, M, 1024, 1024, E); } PH_END(8)
    PH_BEGIN(9) { ln_rows(P.out, (float*)(ws + O_H1), (bf16_t*)(ws + O_H1B), P.ln1_g, P.ln1_b, gw, ngw, lane);
                  cvt_rows(P.p, (bf16_t*)(ws + O_PB), (size_t)M * 256 / 8, gt, ngt); } PH_END(9)
    PH_BEGIN(10) { { EpiFfnIn E{(bf16_t*)(ws + O_ACT)}; gemm_run(lds, (const bf16_t*)(ws + O_H1B), 1024, (const bf16_t*)(ws + W_FFNIN), 1024, M, 5632, 1024, E); }
                   { EpiSg E{(bf16_t*)P.out}; gemm_run(lds, (const bf16_t*)(ws + O_H1B), 1024, (const bf16_t*)(ws + W_PG), 1024, M, 1024, 1024, E); }
                   { EpiStore E{(bf16_t*)P.out + (size_t)M * 1024, 1024}; gemm_run(lds, (const bf16_t*)(ws + O_PB), 256, (const bf16_t*)(ws + W_PLE), 256, M, 1024, 256, E); } } PH_END(10)
    PH_BEGIN(11) { EpiFfnOut E{(float*)(ws + O_H1), (const bf16_t*)P.out, (const bf16_t*)P.out + (size_t)M * 1024}; gemm_run(lds, (const bf16_t*)(ws + O_ACT), FF, (const bf16_t*)(ws + W_FFNOUT), FF, M, 1024, FF, E); } PH_END(11)
    PH_BEGIN(12) ln_rows((const float*)(ws + O_H1), P.out, nullptr, P.ln2_g, P.ln2_b, gw, ngw, lane); PH_END(12)
}

extern "C" void kernel_launch(void* const* d_in, const int* in_sizes, int n_in, void* d_out, int out_size, void* d_ws, size_t ws_size, hipStream_t stream) {
    static int grid = 0;
    if (grid == 0) {
        int dev = 0, cus = 0, per_cu = 0;
        (void)hipGetDevice(&dev);
        (void)hipDeviceGetAttribute(&cus, hipDeviceAttributeMultiprocessorCount, dev);
        (void)hipFuncSetAttribute((const void*)mega, hipFuncAttributeMaxDynamicSharedMemorySize, LDS_BYTES);
        (void)hipOccupancyMaxActiveBlocksPerMultiprocessor(&per_cu, (const void*)mega, NTHREADS, LDS_BYTES);
        if (per_cu < 1) per_cu = 1;
        grid = cus * per_cu;
        if (ws_size < 256 * MiB) { fprintf(stderr, "workspace too small: %zu\n", ws_size); grid = -1; }
    }
    if (grid < 0) return;
    (void)hipMemsetAsync((unsigned char*)d_ws + O_BAR, 0, 4096, stream);
    Params P{};
    const float** pf = (const float**)&P;
    for (int i = 0; i < 24; ++i) pf[i] = (const float*)d_in[i];
    P.out = (float*)d_out; P.ws = (unsigned char*)d_ws;
#if NLAUNCH == 1
    P.ph_lo = 0; P.ph_hi = NPH;
    { void* args[] = {&P}; hipError_t e = hipLaunchCooperativeKernel((const void*)mega, dim3(grid), dim3(NTHREADS), args, LDS_BYTES, stream);
      if (e != hipSuccess) fprintf(stderr, "cooperative launch failed: %s\n", hipGetErrorString(e)); }
#else
    for (int ph = 0; ph < NPH; ++ph) { P.ph_lo = ph; P.ph_hi = ph + 1; void* args[] = {&P};
        hipError_t e = hipLaunchCooperativeKernel((const void*)mega, dim3(grid), dim3(NTHREADS), args, LDS_BYTES, stream);
        if (e != hipSuccess) { fprintf(stderr, "cooperative launch failed: %s\n", hipGetErrorString(e)); break; } }
#endif
}
```

```cpp
#include <hip/hip_runtime.h>
#include <hip/hip_cooperative_groups.h>
#include <cstdint>
#include <cstdio>
namespace cg = cooperative_groups;

#define DI __device__ __forceinline__
typedef unsigned short bf16_t;
typedef short bf16x8 __attribute__((ext_vector_type(8)));
typedef float f32x4 __attribute__((ext_vector_type(4)));
typedef float f32x2 __attribute__((ext_vector_type(2)));
typedef unsigned u32x4 __attribute__((ext_vector_type(4)));
typedef unsigned u32x2 __attribute__((ext_vector_type(2)));

#ifndef NLAUNCH
#define NLAUNCH 1
#endif

constexpr int Bn = 4, S = 4096, D = 1024, M = Bn * S;
constexpr int NA = 3840, NB = 3072, NIN = NA + NB;
constexpr int FF = 2816;
constexpr int NTHREADS = 512, NWAVES = 8;
constexpr int LDS_BYTES = 147456;
constexpr float ALPHA = 1.189207115002721f;
constexpr float C2 = 0.07216878364870322f * 1.4426950408889634f;

constexpr size_t MiB = 1u << 20;
constexpr size_t W_IN = 0, W_UQ = W_IN + (size_t)NIN * 1024 * 2, W_UKV = W_UQ + (size_t)1536 * 384 * 2, W_BRDN = W_UKV + (size_t)2048 * 256 * 2,
                 W_BRMLA = W_BRDN + 2 * MiB, W_O = W_BRMLA + 3 * MiB, W_FFNIN = W_O + 2 * MiB, W_FFNOUT = W_FFNIN + (size_t)5632 * 1024 * 2,
                 W_PG = W_FFNOUT + (size_t)1024 * FF * 2, W_PLE = W_PG + 2 * MiB, W_END = W_PLE + (size_t)1024 * 256 * 2;
static_assert(W_END <= 41 * MiB + 768 * 1024, "weights");
constexpr size_t O_BAR = 41 * MiB + 768 * 1024;
constexpr size_t O_AB = 42 * MiB, O_EGL = O_AB, O_BETA = 43 * MiB, O_GG = 43 * MiB + MiB / 2, O_CQ = 44 * MiB, O_PB = O_CQ, O_CKV = 56 * MiB, O_KR = 64 * MiB;
constexpr size_t ARENA = 66 * MiB;
constexpr size_t O_PROJA = ARENA, O_DV = 224 * MiB;
constexpr size_t O_WT = ARENA, O_INTRA = ARENA + 32 * MiB, O_Q = ARENA + 44 * MiB, O_KN = ARENA + 92 * MiB, O_V = ARENA + 124 * MiB;
constexpr size_t O_Z = ARENA, O_GD = O_KN, O_GM = O_V;
constexpr size_t O_H1 = ARENA, O_H1B = ARENA + 64 * MiB, O_ACT = ARENA + 96 * MiB;
static_assert(O_V + 32 * MiB <= O_DV && O_PROJA + 120 * MiB <= O_DV && O_ACT + 88 * MiB <= 256 * MiB && O_DV + 32 * MiB <= 256 * MiB, "ws map");

struct Params {
    const float* x; const float* p; const int* pos; const float* w_in; const float* conv_w; const float* a_log; const float* dt_bias; const float* dn_norm_w;
    const float* q_norm_w; const float* w_uq; const float* kv_norm_w; const float* w_uk; const float* w_uv; const float* w_br_dn; const float* w_br_mla; const float* w_o;
    const float* ln1_g; const float* ln1_b; const float* w_ffn_in; const float* w_ffn_out; const float* w_ple; const float* w_ple_gate; const float* ln2_g; const float* ln2_b;
    float* out; unsigned char* ws; int ph_lo, ph_hi;
};

DI unsigned f2bf(float f) { unsigned u = __float_as_uint(f); return (u + 0x7fffu + ((u >> 16) & 1u)) >> 16; }
DI unsigned pk2(float lo, float hi) { return f2bf(lo) | (f2bf(hi) << 16); }
DI float bflo(unsigned u) { return __uint_as_float(u << 16); }
DI float bfhi(unsigned u) { return __uint_as_float(u & 0xffff0000u); }
DI float bf2f(bf16_t b) { return __uint_as_float(((unsigned)b) << 16); }
DI float sigm(float x) { return 1.f / (1.f + __expf(-x)); }
DI float silu(float x) { return x / (1.f + __expf(-x)); }
DI float wave_sum(float v) {
#pragma unroll
    for (int o = 1; o < 64; o <<= 1) v += __shfl_xor(v, o);
    return v;
}
DI float wave_max(float v) {
#pragma unroll
    for (int o = 1; o < 64; o <<= 1) v = fmaxf(v, __shfl_xor(v, o));
    return v;
}
DI void st4(bf16_t* p, f32x4 v) { u32x2 w; w.x = pk2(v[0], v[1]); w.y = pk2(v[2], v[3]); *(u32x2*)p = w; }
DI f32x4 ld4(const bf16_t* p) { const u32x2 w = *(const u32x2*)p; return (f32x4){bflo(w.x), bfhi(w.x), bflo(w.y), bfhi(w.y)}; }
DI void rope_cs(int pos, int i, float& c, float& s) {
    const float inv = exp2f(-(float)i * (13.287712379549449f / 32.f));
    const float ang = (float)pos * inv;
    const double a = (double)ang; const double k = rint(a * 0.15915494309189535); const float r = (float)(a - k * 6.283185307179586);
    c = __cosf(r); s = __sinf(r);
}

DI void transpose_item(const float* __restrict__ W, int K, int ldw, bf16_t* __restrict__ WT, int mode, int it, int lane, unsigned char* lds_) {
    typedef __attribute__((address_space(3))) float lfloat;
    lfloat* scr = (lfloat*)((__attribute__((address_space(3))) unsigned char*)lds_ + (threadIdx.x >> 6) * 8448);
    const int nkb = K / 64;
    {
        const int nb = it / nkb, kb = it % nkb, n = nb * 32 + (lane & 31), k0 = kb * 64;
        int sc = n;
        if (mode == 1) { if (n < 3072) sc = n; else if (n < 3792) sc = n + 1024; else if (n < 3840) sc = -1; else { const int nn = n - 3840; sc = nn < 1024 ? nn + 3072 : nn + 3792; } }
        else if (mode == 6) { sc = n < 1024 ? n + 3072 : n + 3792; }
        else if (mode == 3) { const int t = n >> 8, w = n & 255; sc = w < 128 ? 128 * t + w : 2816 + 128 * t + (w - 128); }
        else if (mode == 4) { const int h = n / 192, d = n % 192; if (d >= 128) { const int r = d - 128; sc = h * 192 + 128 + (r >> 1) + 32 * (r & 1); } }
        int kr = k0; if (mode == 5) { const int hh = kb / 3, part = kb % 3; kr = hh * 128 + part * 64; if (part == 2) sc = -1; }
#pragma unroll 16
        for (int i = 0; i < 32; ++i) { const int kk = 2 * i + (lane >> 5); scr[kk * 33 + (lane & 31)] = sc >= 0 ? W[(size_t)(kr + kk) * ldw + sc] : 0.f; }
        asm volatile("s_waitcnt lgkmcnt(0)" ::: "memory");
        const int c = lane & 7;
#pragma unroll
        for (int j = 0; j < 4; ++j) { const int nn = (lane >> 3) + 8 * j; const lfloat* s = scr + (8 * c) * 33 + nn;
            u32x4 o; o.x = pk2(s[0 * 33], s[1 * 33]); o.y = pk2(s[2 * 33], s[3 * 33]); o.z = pk2(s[4 * 33], s[5 * 33]); o.w = pk2(s[6 * 33], s[7 * 33]);
            *(u32x4*)(WT + (size_t)(nb * 32 + nn) * K + k0 + 8 * c) = o; }
        asm volatile("s_waitcnt lgkmcnt(0)" ::: "memory");
    }
}
DI void transpose_mat(const float* __restrict__ W, int K, int ldw, bf16_t* __restrict__ WT, int nrows, int mode, int gw, int ngw, int lane, unsigned char* lds_) {
    const int nitems = (nrows / 32) * (K / 64);
    for (int it = gw; it < nitems; it += ngw) transpose_item(W, K, ldw, WT, mode, it, lane, lds_);
}
DI void transpose_rest(const Params& P, int gw, int ngw, int lane, unsigned char* lds_) {
    unsigned char* ws = P.ws;
    constexpr int I0 = (1536 / 32) * (384 / 64), I1 = I0 + 2 * (1024 / 32) * (256 / 64), I2 = I1 + (NB / 32) * 16, I3 = I2 + 32 * 16, I4 = I3 + 32 * 24, I5 = I4 + 32 * 16,
                  I6 = I5 + (5632 / 32) * 16, I7 = I6 + 32 * (FF / 64), I8 = I7 + 32 * 16, I9 = I8 + 32 * 4;
    for (int g = gw; g < I9; g += ngw) {
        if (g < I0) transpose_item(P.w_uq, 384, 1536, (bf16_t*)(ws + W_UQ), 4, g, lane, lds_);
        else if (g < I1) { const int q = g - I0; if (q < 128) transpose_item(P.w_uk, 256, 1024, (bf16_t*)(ws + W_UKV), 0, q, lane, lds_); else transpose_item(P.w_uv, 256, 1024, (bf16_t*)(ws + W_UKV) + (size_t)1024 * 256, 0, q - 128, lane, lds_); }
        else if (g < I2) transpose_item(P.w_in, 1024, 6864, (bf16_t*)(ws + W_IN) + (size_t)NA * 1024, 6, g - I1, lane, lds_);
        else if (g < I3) transpose_item(P.w_br_dn, 1024, 1024, (bf16_t*)(ws + W_BRDN), 0, g - I2, lane, lds_);
        else if (g < I4) transpose_item(P.w_br_mla, 1536, 1024, (bf16_t*)(ws + W_BRMLA), 5, g - I3, lane, lds_);
        else if (g < I5) transpose_item(P.w_o, 1024, 1024, (bf16_t*)(ws + W_O), 0, g - I4, lane, lds_);
        else if (g < I6) transpose_item(P.w_ffn_in, 1024, 5632, (bf16_t*)(ws + W_FFNIN), 3, g - I5, lane, lds_);
        else if (g < I7) transpose_item(P.w_ffn_out, FF, 1024, (bf16_t*)(ws + W_FFNOUT), 0, g - I6, lane, lds_);
        else if (g < I8) transpose_item(P.w_ple_gate, 1024, 1024, (bf16_t*)(ws + W_PG), 0, g - I7, lane, lds_);
        else transpose_item(P.w_ple, 256, 1024, (bf16_t*)(ws + W_PLE), 0, g - I8, lane, lds_);
    }
}
DI void cvt_rows(const float* __restrict__ src, bf16_t* __restrict__ dst, size_t n8, size_t gt, size_t ngt) {
#pragma unroll 4
    for (size_t i = gt; i < n8; i += ngt) { const f32x4 a = *(const f32x4*)(src + i * 8), b = *(const f32x4*)(src + i * 8 + 4);
        u32x4 o; o.x = pk2(a[0], a[1]); o.y = pk2(a[2], a[3]); o.z = pk2(b[0], b[1]); o.w = pk2(b[2], b[3]); *(u32x4*)(dst + i * 8) = o; }
}

namespace pg8 {
#define PG8_LAS __attribute__((address_space(3)))
constexpr int BM = 256, BK = 64, HALF = 128, HTB = HALF * BK * 2, STAGE_BYTES = 8 * HTB, NXCD = 8, WGM = 8;
DI int lds_byte(int r, int c) { const int st = (r >> 4) * 2 + (c >> 5), rr = r & 15, cc = c & 31, ob = rr * 64 + cc * 2; return st * 1024 + (ob ^ (((ob >> 9) & 1) << 5)); }
DI void stage_rc(int b, int& R, int& C) { const int st = b / 1024, sb = b % 1024, swz = sb ^ (((sb >> 9) & 1) << 5); R = (st >> 1) * 16 + swz / 64; C = (st & 1) * 32 + (swz % 64) / 2; }
struct Unit { int pm, pn; };
struct Gemm { const bf16_t* A; const bf16_t* Bt; int M, N, K, lda, ldb; };
struct StaticOrder {
    int nM, nN, nwg, G, c;
    DI void init(int M_, int N_, int G_, int c_) { nM = M_ / BM; nN = N_ / BM; nwg = nM * nN; G = G_; c = c_; }
    DI bool next(int i, Unit& u) const {
        const long L = (long)i * G + c; if (L >= nwg) return false;
        int wgid = (int)L; { const int q = nwg / NXCD, r = nwg % NXCD, xcd = wgid % NXCD, off = wgid / NXCD; wgid = (xcd < r ? xcd * (q + 1) : r * (q + 1) + (xcd - r) * q) + off; }
        const int nig = WGM * nN, gid = wgid / nig, fm = gid * WGM, gsz = (nM - fm) < WGM ? (nM - fm) : WGM;
        u.pm = fm + ((wgid % nig) % gsz); u.pn = (wgid % nig) / gsz; return true;
    }
};
template <class Epi>
DI void gemm_phase(PG8_LAS unsigned char* lds, const Gemm g, const StaticOrder& S, const Epi& E) {
    const int tid = threadIdx.x, wid = __builtin_amdgcn_readfirstlane(tid >> 6), lane = tid & 63, wr = wid >> 2, wc = wid & 3, fr = lane & 15, fq = lane >> 4;
    const int K = g.K, nt = K / BK;
    unsigned voffA[2], voffB[2];
#pragma unroll
    for (int i = 0; i < 2; ++i) { int R, C; stage_rc(tid * 16 + i * 8192, R, C); voffA[i] = (unsigned)(R * g.lda + C) * 2u; voffB[i] = (unsigned)(R * g.ldb + C) * 2u; }
    const size_t kstep = (size_t)(BK * 2);
    const size_t hstepA = (size_t)HALF * g.lda * 2, hstepB = (size_t)HALF * g.ldb * 2;
    const size_t tstepA = 2 * hstepA, tstepB = 2 * hstepB;
    const unsigned ldsw = (unsigned)wid * 1024u;
    const int aoff = lds_byte(wr * 64 + fr, fq * 8), boff = lds_byte(wc * 32 + fr, fq * 8);
#define PG8_SA(b, h) (((b) * 2 + (h)) * HTB)
#define PG8_SB(b, h) ((4 + (b) * 2 + (h)) * HTB)
#define PG8_STAGE(bufoff, gbase, voff) do { _Pragma("unroll") for (int _i = 0; _i < 2; ++_i) \
        __builtin_amdgcn_global_load_lds((const unsigned*)((const char*)(gbase) + (voff)[_i]), (PG8_LAS unsigned*)(lds + (bufoff) + ldsw + _i * 8192), 16, 0, 0); } while (0)
#define PG8_LDA(dst, b, h) do { _Pragma("unroll") for (int m = 0; m < 4; ++m) _Pragma("unroll") for (int k = 0; k < 2; ++k) dst[m][k] = *(const PG8_LAS bf16x8*)(lds + PG8_SA(b, h) + aoff + m * 2048 + k * 1024); } while (0)
#define PG8_LDB(dst, b, h) do { _Pragma("unroll") for (int n = 0; n < 2; ++n) _Pragma("unroll") for (int k = 0; k < 2; ++k) dst[n][k] = *(const PG8_LAS bf16x8*)(lds + PG8_SB(b, h) + boff + n * 2048 + k * 1024); } while (0)
#define PG8_MMA(ai, bj, At, Bt) do { __builtin_amdgcn_s_setprio(1); _Pragma("unroll") for (int m = 0; m < 4; ++m) _Pragma("unroll") for (int n = 0; n < 2; ++n) _Pragma("unroll") for (int k = 0; k < 2; ++k) \
        acc[ai][bj][m][n] = __builtin_amdgcn_mfma_f32_16x16x32_bf16(Bt[n][k], At[m][k], acc[ai][bj][m][n], 0, 0, 0); __builtin_amdgcn_s_setprio(0); } while (0)
#define PG8_WAIT_V(n) asm volatile("s_waitcnt vmcnt(" #n ")" ::: "memory")
#define PG8_WAIT_L(n) asm volatile("s_waitcnt lgkmcnt(" #n ")" ::: "memory")
#define PG8_BAR __builtin_amdgcn_s_barrier()
#define PG8_SCHED __builtin_amdgcn_sched_barrier(0)
    Unit cur, nxt; int ui = 0;
    if (!S.next(0, cur)) return;
    f32x4 acc[2][2][4][2];
#pragma unroll
    for (int a = 0; a < 2; ++a)
#pragma unroll
        for (int b = 0; b < 2; ++b)
#pragma unroll
            for (int m = 0; m < 4; ++m)
#pragma unroll
                for (int n = 0; n < 2; ++n) acc[a][b][m][n] = (f32x4){0.f, 0.f, 0.f, 0.f};
    bf16x8 At[4][2], B0[2][2], B1[2][2];
    const char* cA = (const char*)g.A + (size_t)cur.pm * tstepA; const char* cB = (const char*)g.Bt + (size_t)cur.pn * tstepB;
    PG8_STAGE(PG8_SB(0, 0), cB, voffB); PG8_STAGE(PG8_SB(0, 1), cB + hstepB, voffB); PG8_STAGE(PG8_SA(0, 0), cA, voffA); PG8_STAGE(PG8_SA(0, 1), cA + hstepA, voffA);
    if (wr == 1) PG8_BAR;
    PG8_WAIT_V(2); PG8_BAR;
    PG8_STAGE(PG8_SB(1, 0), cB + kstep, voffB); PG8_STAGE(PG8_SA(1, 0), cA + kstep, voffA); PG8_STAGE(PG8_SB(1, 1), cB + hstepB + kstep, voffB);
    PG8_WAIT_V(6); PG8_BAR;
    for (;;) {
        const bool has_next = S.next(ui + 1, nxt);
        const char* nA = has_next ? (const char*)g.A + (size_t)nxt.pm * tstepA : cA; const char* nB = has_next ? (const char*)g.Bt + (size_t)nxt.pn * tstepB : cB;
#pragma unroll 1
        for (int t = 0; t < nt; t += 2) {
            const bool last = (t == nt - 2);
            const char* a1 = cA + (size_t)(t + 1) * kstep;
            const char* a2 = last ? nA : cA + (size_t)(t + 2) * kstep; const char* b2 = last ? nB : cB + (size_t)(t + 2) * kstep;
            const char* a3 = a2 + kstep; const char* b3 = b2 + kstep;
            PG8_LDB(B0, 0, 0); PG8_LDB(B1, 0, 1); PG8_SCHED; PG8_LDA(At, 0, 0); PG8_STAGE(PG8_SA(1, 1), a1 + hstepA, voffA);
            PG8_WAIT_V(8); PG8_WAIT_L(0); PG8_BAR; PG8_MMA(0, 0, At, B0); PG8_MMA(0, 1, At, B1); PG8_BAR; PG8_SCHED;
            PG8_LDA(At, 0, 1); PG8_STAGE(PG8_SB(0, 0), b2, voffB); PG8_STAGE(PG8_SB(0, 1), b2 + hstepB, voffB); PG8_STAGE(PG8_SA(0, 0), a2, voffA);
            PG8_WAIT_V(8); PG8_WAIT_L(0); PG8_BAR; PG8_MMA(1, 0, At, B0); PG8_MMA(1, 1, At, B1); PG8_BAR; PG8_SCHED;
            PG8_LDB(B0, 1, 0); PG8_LDB(B1, 1, 1); PG8_SCHED; PG8_LDA(At, 1, 0); PG8_STAGE(PG8_SA(0, 1), a2 + hstepA, voffA);
            PG8_WAIT_V(8); PG8_WAIT_L(0); PG8_BAR; PG8_MMA(0, 0, At, B0); PG8_MMA(0, 1, At, B1); PG8_BAR; PG8_SCHED;
            PG8_LDA(At, 1, 1); PG8_STAGE(PG8_SB(1, 0), b3, voffB); PG8_STAGE(PG8_SB(1, 1), b3 + hstepB, voffB); PG8_STAGE(PG8_SA(1, 0), a3, voffA);
            PG8_WAIT_V(8); PG8_WAIT_L(0); PG8_BAR; PG8_MMA(1, 0, At, B0); PG8_MMA(1, 1, At, B1); PG8_BAR; PG8_SCHED;
        }
        if (wr == 0) PG8_BAR;
        {
            const int row0 = cur.pm * BM + wr * 64 + fr, col0 = cur.pn * BM + wc * 32 + 4 * fq;
#pragma unroll
            for (int ai = 0; ai < 2; ++ai)
#pragma unroll
                for (int m = 0; m < 4; ++m)
#pragma unroll
                    for (int n = 0; n < 2; ++n) E(row0 + ai * HALF + m * 16, col0 + n * 16, acc[ai][0][m][n], acc[ai][1][m][n]);
        }
        if (!has_next) break;
#pragma unroll
        for (int a = 0; a < 2; ++a)
#pragma unroll
            for (int b = 0; b < 2; ++b)
#pragma unroll
                for (int m = 0; m < 4; ++m)
#pragma unroll
                    for (int n = 0; n < 2; ++n) acc[a][b][m][n] = (f32x4){0.f, 0.f, 0.f, 0.f};
        cur = nxt; cA = nA; cB = nB; ++ui;
        if (wr == 1) PG8_BAR;
    }
    PG8_WAIT_V(0);
    PG8_BAR;
#undef PG8_SA
#undef PG8_SB
#undef PG8_STAGE
#undef PG8_LDA
#undef PG8_LDB
#undef PG8_MMA
#undef PG8_WAIT_V
#undef PG8_WAIT_L
#undef PG8_BAR
#undef PG8_SCHED
}
}
template <class Epi>
DI void gemm_run(unsigned char* lds, const bf16_t* A, int lda, const bf16_t* Bt, int ldb, int Mm, int N, int K, const Epi& E) {
    pg8::Gemm g{A, Bt, Mm, N, K, lda, ldb}; pg8::StaticOrder S; S.init(Mm, N, (int)gridDim.x, (int)blockIdx.x);
    pg8::gemm_phase((PG8_LAS unsigned char*)lds, g, S, E);
}

struct EpiProjA { bf16_t* O; float* AB;
    DI void operator()(int r, int c, f32x4 a, f32x4 b) const { bf16_t* o = O + (size_t)r * NA + c; st4(o, a); st4(o + 128, b);
        if (c >= 3072 && c < 3088) *(f32x4*)(AB + (size_t)r * 16 + (c - 3072)) = a; } };
struct EpiStore { bf16_t* O; int ldo;
    DI void operator()(int r, int c, f32x4 a, f32x4 b) const { bf16_t* o = O + (size_t)r * ldo + c; st4(o, a); st4(o + 128, b); } };
struct EpiQ { bf16_t* O;
    DI void operator()(int r, int c, f32x4 a, f32x4 b) const { bf16_t* o = O + (size_t)r * 1536 + c; st4(o, a * C2); st4(o + 128, b * C2); } };
struct EpiKV { bf16_t* KN; bf16_t* V;
    DI void one(int r, int c, f32x4 v) const { if (c < 1024) st4(KN + (size_t)r * 1024 + c, v); else st4(V + (size_t)r * 1024 + c - 1024, v); }
    DI void operator()(int r, int c, f32x4 a, f32x4 b) const { one(r, c, a); one(r, c + 128, b); } };
struct EpiZG { bf16_t* Z; bf16_t* GD; bf16_t* GM;
    DI void one(int r, int c, f32x4 v) const { bf16_t* o = c < 1024 ? Z + c : (c < 2048 ? GD + (c - 1024) : GM + (c - 2048)); st4(o + (size_t)r * 1024, v); }
    DI void operator()(int r, int c, f32x4 a, f32x4 b) const { one(r, c, a); one(r, c + 128, b); } };
struct EpiYdn { bf16_t* GD;
    DI void one(int r, int c, f32x4 v) const { bf16_t* g = GD + (size_t)r * 1024 + c; const f32x4 gv = ld4(g);
        st4(g, (f32x4){sigm(gv[0]) * v[0], sigm(gv[1]) * v[1], sigm(gv[2]) * v[2], sigm(gv[3]) * v[3]}); }
    DI void operator()(int r, int c, f32x4 a, f32x4 b) const { one(r, c, a); one(r, c + 128, b); } };
struct EpiYmla { const bf16_t* GD; bf16_t* GM;
    DI void one(int r, int c, f32x4 v) const { bf16_t* g = GM + (size_t)r * 1024 + c; const f32x4 gv = ld4(g), tv = ld4(GD + (size_t)r * 1024 + c);
        st4(g, (f32x4){tv[0] + sigm(gv[0]) * v[0], tv[1] + sigm(gv[1]) * v[1], tv[2] + sigm(gv[2]) * v[2], tv[3] + sigm(gv[3]) * v[3]}); }
    DI void operator()(int r, int c, f32x4 a, f32x4 b) const { one(r, c, a); one(r, c + 128, b); } };
struct EpiWo { const float* x; float* T1;
    DI void one(int r, int c, f32x4 v) const { const size_t o = (size_t)r * D + c; *(f32x4*)(T1 + o) = *(const f32x4*)(x + o) * ALPHA + v; }
    DI void operator()(int r, int c, f32x4 a, f32x4 b) const { one(r, c, a); one(r, c + 128, b); } };
struct EpiFfnIn { bf16_t* ACT;
    DI void operator()(int r, int c, f32x4 a, f32x4 b) const { const int t = c >> 8, j = c & 255;
        st4(ACT + (size_t)r * FF + 128 * t + j, (f32x4){silu(a[0]) * b[0], silu(a[1]) * b[1], silu(a[2]) * b[2], silu(a[3]) * b[3]}); } };
struct EpiSg { bf16_t* SG;
    DI void one(int r, int c, f32x4 v) const { st4(SG + (size_t)r * D + c, (f32x4){sigm(v[0]), sigm(v[1]), sigm(v[2]), sigm(v[3])}); }
    DI void operator()(int r, int c, f32x4 a, f32x4 b) const { one(r, c, a); one(r, c + 128, b); } };
struct EpiFfnOut { float* H1; const bf16_t* SG; const bf16_t* PLE0;
    DI void one(int r, int c, f32x4 v) const { const size_t o = (size_t)r * D + c; *(f32x4*)(H1 + o) = *(const f32x4*)(H1 + o) * ALPHA + v + ld4(SG + o) * ld4(PLE0 + o); }
    DI void operator()(int r, int c, f32x4 a, f32x4 b) const { one(r, c, a); one(r, c + 128, b); } };

DI float sum16(float v) { v += __shfl_xor(v, 1); v += __shfl_xor(v, 2); v += __shfl_xor(v, 4); v += __shfl_xor(v, 8); return v; }
DI void unpack8(float* f, u32x4 u) { f[0] = bflo(u.x); f[1] = bfhi(u.x); f[2] = bflo(u.y); f[3] = bfhi(u.y); f[4] = bflo(u.z); f[5] = bfhi(u.z); f[6] = bflo(u.w); f[7] = bfhi(u.w); }
DI void p2_tokens(const Params& P, int gw, int ngw, int lane) {
    unsigned char* ws = P.ws;
    const bf16_t* PA = (const bf16_t*)(ws + O_PROJA); const float* AB = (const float*)(ws + O_AB);
    bf16_t* DQ = (bf16_t*)P.out; bf16_t* DK = DQ + (size_t)M * 1024; bf16_t* DV = (bf16_t*)(ws + O_DV);
    float* BETA = (float*)(ws + O_BETA); float* GG = (float*)(ws + O_GG);
    bf16_t* CQ = (bf16_t*)(ws + O_CQ); bf16_t* CKV = (bf16_t*)(ws + O_CKV); bf16_t* KR = (bf16_t*)(ws + O_KR);
    for (int it = gw; it < 6 * (M / 32); it += ngw) {
        const int seg = it % 6, m0 = (it / 6) * 32;
        const int c0 = seg * 512 + 8 * lane;
        float w[4][8];
#pragma unroll
        for (int i = 0; i < 4; ++i) { const f32x4 a = *(const f32x4*)(P.conv_w + i * 3072 + c0), b = *(const f32x4*)(P.conv_w + i * 3072 + c0 + 4);
            w[i][0] = a[0]; w[i][1] = a[1]; w[i][2] = a[2]; w[i][3] = a[3]; w[i][4] = b[0]; w[i][5] = b[1]; w[i][6] = b[2]; w[i][7] = b[3]; }
        float xw[3][8];
        const bool first = (m0 % S) == 0;
#pragma unroll
        for (int i = 0; i < 3; ++i) { u32x4 u = (u32x4){0u, 0u, 0u, 0u}; if (!first) u = *(const u32x4*)(PA + (size_t)(m0 - 3 + i) * NA + c0); unpack8(xw[i], u); }
        bf16_t* dst = (seg < 2 ? DQ : (seg < 4 ? DK : DV)) + (seg & 1) * 512 + 8 * lane;
        const float qs = seg < 2 ? 0.08838834764831845f : 1.f;
        for (int t = 0; t < 32; t += 4) {
            u32x4 un[4];
#pragma unroll
            for (int q = 0; q < 4; ++q) un[q] = *(const u32x4*)(PA + (size_t)(m0 + t + q) * NA + c0);
#pragma unroll
            for (int q = 0; q < 4; ++q) {
                float xc[8]; unpack8(xc, un[q]);
                float a[8]; float ss = 0.f;
#pragma unroll
                for (int j = 0; j < 8; ++j) { a[j] = silu(w[0][j] * xw[0][j] + w[1][j] * xw[1][j] + w[2][j] * xw[2][j] + w[3][j] * xc[j]); ss += a[j] * a[j]; }
                if (seg < 4) { const float r = rsqrtf(sum16(ss) + 1e-6f) * qs;
#pragma unroll
                    for (int j = 0; j < 8; ++j) a[j] *= r; }
                u32x4 o; o.x = pk2(a[0], a[1]); o.y = pk2(a[2], a[3]); o.z = pk2(a[4], a[5]); o.w = pk2(a[6], a[7]);
                *(u32x4*)(dst + (size_t)(m0 + t + q) * 1024) = o;
#pragma unroll
                for (int j = 0; j < 8; ++j) { xw[0][j] = xw[1][j]; xw[1][j] = xw[2][j]; xw[2][j] = xc[j]; }
            }
        }
    }
    const int sub = lane >> 4, l16 = lane & 15;
    for (int it = gw; it < M / 4; it += ngw) {
        const int m = it * 4 + sub;
        const bf16_t* row = PA + (size_t)m * NA;
        if (l16 < 8) { const float br = AB[(size_t)m * 16 + l16], ar = AB[(size_t)m * 16 + 8 + l16];
            BETA[(size_t)m * 8 + l16] = sigm(br);
            const float xx = ar + P.dt_bias[l16]; const float sp = fmaxf(xx, 0.f) + log1pf(__expf(-fabsf(xx)));
            GG[(size_t)m * 8 + l16] = -__expf(P.a_log[l16]) * sp; }
        {
            float v[3][8]; float ss = 0.f;
#pragma unroll
            for (int j = 0; j < 3; ++j) { unpack8(v[j], *(const u32x4*)(row + 3088 + 8 * (l16 + 16 * j)));
#pragma unroll
                for (int e = 0; e < 8; ++e) ss += v[j][e] * v[j][e]; }
            const float r = rsqrtf(sum16(ss) * (1.f / 384.f) + 1e-6f);
#pragma unroll
            for (int j = 0; j < 3; ++j) { const int idx = 8 * (l16 + 16 * j); const f32x4 wa = *(const f32x4*)(P.q_norm_w + idx), wb = *(const f32x4*)(P.q_norm_w + idx + 4);
                u32x4 o; o.x = pk2(v[j][0] * r * wa[0], v[j][1] * r * wa[1]); o.y = pk2(v[j][2] * r * wa[2], v[j][3] * r * wa[3]); o.z = pk2(v[j][4] * r * wb[0], v[j][5] * r * wb[1]); o.w = pk2(v[j][6] * r * wb[2], v[j][7] * r * wb[3]);
                *(u32x4*)(CQ + (size_t)m * 384 + idx) = o; }
        }
        {
            float v[2][8]; float ss = 0.f;
#pragma unroll
            for (int j = 0; j < 2; ++j) { unpack8(v[j], *(const u32x4*)(row + 3472 + 8 * (l16 + 16 * j)));
#pragma unroll
                for (int e = 0; e < 8; ++e) ss += v[j][e] * v[j][e]; }
            const float r = rsqrtf(sum16(ss) * (1.f / 256.f) + 1e-6f);
#pragma unroll
            for (int j = 0; j < 2; ++j) { const int idx = 8 * (l16 + 16 * j); const f32x4 wa = *(const f32x4*)(P.kv_norm_w + idx), wb = *(const f32x4*)(P.kv_norm_w + idx + 4);
                u32x4 o; o.x = pk2(v[j][0] * r * wa[0], v[j][1] * r * wa[1]); o.y = pk2(v[j][2] * r * wa[2], v[j][3] * r * wa[3]); o.z = pk2(v[j][4] * r * wb[0], v[j][5] * r * wb[1]); o.w = pk2(v[j][6] * r * wb[2], v[j][7] * r * wb[3]);
                *(u32x4*)(CKV + (size_t)m * 256 + idx) = o; }
        }
        {
            const unsigned ua = *(const unsigned*)(row + 3728 + 2 * l16), ub = *(const unsigned*)(row + 3728 + 32 + 2 * l16);
            const int ps = P.pos[m]; float c0_, s0_, c1_, s1_; rope_cs(ps, 2 * l16, c0_, s0_); rope_cs(ps, 2 * l16 + 1, c1_, s1_);
            const float a1 = bflo(ua), a2 = bflo(ub), b1 = bfhi(ua), b2 = bfhi(ub);
            u32x2 o; o.x = pk2(a1 * c0_ - a2 * s0_, a2 * c0_ + a1 * s0_); o.y = pk2(b1 * c1_ - b2 * s1_, b2 * c1_ + b1 * s1_);
            *(u32x2*)(KR + (size_t)m * 64 + 4 * l16) = o;
        }
    }
}

typedef float f32x16 __attribute__((ext_vector_type(16)));
typedef short s16x4 __attribute__((ext_vector_type(4)));
#define LAS __attribute__((address_space(3)))
typedef LAS unsigned char* lptr;
DI s16x4 vtr(lptr p) { return __builtin_bit_cast(s16x4, __builtin_amdgcn_ds_read_tr16_b64_v4i16((LAS s16x4*)p)); }
#define MFMA32(a, b, c) __builtin_amdgcn_mfma_f32_32x32x16_bf16((a), (b), (c), 0, 0, 0)
DI bf16x8 pack8(const f32x16& x, int o) { u32x4 p; p.x = pk2(x[o], x[o + 1]); p.y = pk2(x[o + 2], x[o + 3]); p.z = pk2(x[o + 4], x[o + 5]); p.w = pk2(x[o + 6], x[o + 7]); return __builtin_bit_cast(bf16x8, p); }
DI void attn_unit(const Params& P, unsigned char* lds_, int bh, int qb) {
    lptr lds = (lptr)lds_;
    constexpr int KP = 400, VP = 272, KBUF = 64 * KP, VBUF = 64 * VP;
    unsigned char* ws = P.ws;
    bf16_t* Qg = (bf16_t*)(ws + O_Q); const bf16_t* KN = (const bf16_t*)(ws + O_KN); const bf16_t* V = (const bf16_t*)(ws + O_V); const bf16_t* KR = (const bf16_t*)(ws + O_KR);
    const int tid = threadIdx.x, lane = tid & 63, w = __builtin_amdgcn_readfirstlane(tid >> 6), r32 = lane & 31, hi = lane >> 5;
    const int b = bh >> 3, h = bh & 7;
    const size_t rowb = (size_t)b * S;
    {
        {
            const int q0 = qb * 256, NT = (q0 + 256) / 64;
            const int qrow = q0 + 32 * w + r32;
            bf16x8 qf[12];
            { const bf16_t* qp = Qg + (rowb + qrow) * 1536 + h * 192 + 8 * hi;
#pragma unroll
              for (int ks = 0; ks < 12; ++ks) qf[ks] = *(const bf16x8*)(qp + 16 * ks);
              const int ps = P.pos[rowb + qrow];
#pragma unroll
              for (int ks = 8; ks < 12; ++ks) { u32x4 u = __builtin_bit_cast(u32x4, qf[ks]);
#pragma unroll
                  for (int pj = 0; pj < 4; ++pj) { float c, s; rope_cs(ps, 8 * (ks - 8) + 4 * hi + pj, c, s); const unsigned w = u[pj]; const float t1 = bflo(w), t2 = bfhi(w); u[pj] = pk2(t1 * c - t2 * s, t2 * c + t1 * s); }
                  qf[ks] = __builtin_bit_cast(bf16x8, u); } }
            const bf16_t* kn_src = KN + (rowb + (tid >> 4)) * 1024 + h * 128 + (tid & 15) * 8;
            const bf16_t* kr_src = KR + (rowb + (tid >> 3)) * 64 + (tid & 7) * 8;
            const bf16_t* v_src = V + (rowb + (tid >> 4)) * 1024 + h * 128 + (tid & 15) * 8;
            const int kdst = (tid >> 4) * KP + (tid & 15) * 16, krdst = (tid >> 3) * KP + 256 + (tid & 7) * 16, vdst = (tid >> 4) * VP + (tid & 15) * 16;
            u32x4 st0, st1, st2, st3, st4_;
#define LOADT(kt) do { const size_t o_ = (size_t)(kt) * 64; st0 = *(const u32x4*)(kn_src + o_ * 1024); st1 = *(const u32x4*)(kn_src + (o_ + 32) * 1024); st2 = *(const u32x4*)(kr_src + o_ * 64); \
                       st3 = *(const u32x4*)(v_src + o_ * 1024); st4_ = *(const u32x4*)(v_src + (o_ + 32) * 1024); } while (0)
#define STORET(buf) do { lptr kb_ = lds + (buf) * KBUF; lptr vb_ = lds + 2 * KBUF + (buf) * VBUF; *(LAS u32x4*)(kb_ + kdst) = st0; *(LAS u32x4*)(kb_ + kdst + 32 * KP) = st1; *(LAS u32x4*)(kb_ + krdst) = st2; \
                         *(LAS u32x4*)(vb_ + vdst) = st3; *(LAS u32x4*)(vb_ + vdst + 32 * VP) = st4_; } while (0)
            __syncthreads();
            LOADT(0); STORET(0);
            __syncthreads();
            f32x16 o[4];
#pragma unroll
            for (int d = 0; d < 4; ++d)
#pragma unroll
                for (int i = 0; i < 16; ++i) o[d][i] = 0.f;
            float m_run = -1e30f, l_run = 0.f;
            for (int kt = 0; kt < NT; ++kt) {
                const int buf = kt & 1;
                if (kt + 1 < NT) LOADT(kt + 1);
                if (64 * kt <= q0 + 32 * w + 31) {
                    lptr kb = lds + buf * KBUF + r32 * KP + hi * 16;
                    f32x16 s0, s1;
#pragma unroll
                    for (int i = 0; i < 16; ++i) { s0[i] = 0.f; s1[i] = 0.f; }
#pragma unroll
                    for (int ks = 0; ks < 12; ++ks) { const bf16x8 a0 = *(const LAS bf16x8*)(kb + ks * 32), a1 = *(const LAS bf16x8*)(kb + 32 * KP + ks * 32);
                        s0 = MFMA32(a0, qf[ks], s0); s1 = MFMA32(a1, qf[ks], s1); }
                    if (64 * kt + 63 > q0 + 32 * w) {
                        const int kv0 = 64 * kt + 4 * hi;
#pragma unroll
                        for (int i = 0; i < 16; ++i) { const int kv = kv0 + (i & 3) + 8 * (i >> 2); if (kv > qrow) s0[i] = -1e30f; if (kv + 32 > qrow) s1[i] = -1e30f; }
                    }
                    float mx = fmaxf(s0[0], s1[0]);
#pragma unroll
                    for (int i = 1; i < 16; ++i) mx = fmaxf(mx, fmaxf(s0[i], s1[i]));
                    mx = fmaxf(mx, __shfl_xor(mx, 32));
                    const float m_new = fmaxf(m_run, mx), al = __builtin_amdgcn_exp2f(m_run - m_new); m_run = m_new;
                    float ps = 0.f;
#pragma unroll
                    for (int i = 0; i < 16; ++i) { s0[i] = __builtin_amdgcn_exp2f(s0[i] - m_new); s1[i] = __builtin_amdgcn_exp2f(s1[i] - m_new); ps += s0[i] + s1[i]; }
                    l_run = l_run * al + ps;
#pragma unroll
                    for (int d = 0; d < 4; ++d) o[d] = o[d] * al;
                    bf16x8 pf[4]; pf[0] = pack8(s0, 0); pf[1] = pack8(s0, 8); pf[2] = pack8(s1, 0); pf[3] = pack8(s1, 8);
                    lptr vb = lds + 2 * KBUF + buf * VBUF + (4 * hi + ((lane & 15) >> 2)) * VP + (((lane >> 4) & 1) * 16 + (lane & 3) * 4) * 2;
#pragma unroll
                    for (int s = 0; s < 4; ++s)
#pragma unroll
                        for (int d = 0; d < 4; ++d) { const s16x4 lo = vtr(vb + s * 16 * VP + d * 64), hh = vtr(vb + (s * 16 + 8) * VP + d * 64);
                            const bf16x8 a = __builtin_shufflevector(lo, hh, 0, 1, 2, 3, 4, 5, 6, 7); o[d] = MFMA32(a, pf[s], o[d]); }
                }
                if (kt + 1 < NT) STORET(buf ^ 1);
                __syncthreads();
            }
#undef LOADT
#undef STORET
            l_run += __shfl_xor(l_run, 32);
            const float il = 1.f / l_run;
            bf16_t* op = Qg + (rowb + qrow) * 1536 + h * 192 + 4 * hi;
#pragma unroll
            for (int d = 0; d < 4; ++d)
#pragma unroll
                for (int g = 0; g < 4; ++g) st4(op + 32 * d + 8 * g, (f32x4){o[d][4 * g], o[d][4 * g + 1], o[d][4 * g + 2], o[d][4 * g + 3]} * il);
        }
    }
}

DI void attn_queue(const Params& P, unsigned char* lds_, unsigned* qcnt) {
    LAS int* slot = (LAS int*)((lptr)lds_ + 147392);
    const int myx = blockIdx.x & 7;
    for (int qq = 0; qq < 8; ++qq) {
        const int x = (myx + qq) & 7;
        for (;;) {
            __syncthreads();
            if (threadIdx.x == 0) *slot = (int)__hip_atomic_fetch_add(qcnt + 64 * x, 1u, __ATOMIC_RELAXED, __HIP_MEMORY_SCOPE_AGENT);
            __syncthreads();
            const int k = *slot;
            if (k >= 64) break;
            attn_unit(P, lds_, 4 * x + (k & 3), 15 - (k >> 2));
        }
    }
}

#define LFENCE() asm volatile("s_waitcnt lgkmcnt(0)" ::: "memory")
DI int crow(int r, int hi) { return (r & 3) + 8 * (r >> 2) + 4 * hi; }
DI unsigned char* rawp(unsigned char* basep, size_t m0, int h, int o) { return basep + (m0 + (size_t)(o >> 8)) * 2048 + h * 256 + (o & 255); }
DI void store_raw(unsigned char* p, const f32x16& x) { *(u32x4*)p = __builtin_bit_cast(u32x4, pack8(x, 0)); *(u32x4*)(p + 16) = __builtin_bit_cast(u32x4, pack8(x, 8)); }
DI void delta_A(const Params& P, unsigned char* lds_, int gw, int ngw, int lane, int wid) {
    unsigned char* ws = P.ws;
    lptr base = (lptr)lds_ + wid * 18432;
    LAS float* Lm = (LAS float*)base;
    LAS float* gc = (LAS float*)(base + 17408); LAS float* bu = gc + 64; LAS float* bw = bu + 64; LAS float* tl = bw + 64;
    bf16_t* DQ = (bf16_t*)P.out; const bf16_t* DK = DQ + (size_t)M * 1024; const bf16_t* DV = (const bf16_t*)(ws + O_DV);
    const float* BETA = (const float*)(ws + O_BETA); const float* GG = (const float*)(ws + O_GG); float* EGL = (float*)(ws + O_EGL);
    for (int ch = gw; ch < 2048; ch += ngw) {
        asm volatile("" : "+v"(lane));
        const int r32 = lane & 31, hi = lane >> 5;
        const int h = ch & 7, bn = ch >> 3, b = bn >> 6, n = bn & 63; const size_t m0 = (size_t)b * S + 64 * n;
        LFENCE();
        {
            float g = GG[(m0 + lane) * 8 + h]; const float be = BETA[(m0 + lane) * 8 + h];
#pragma unroll
            for (int o = 1; o < 64; o <<= 1) { const float t = __shfl_up(g, o); if (lane >= o) g += t; }
            const float gl = __shfl(g, 63);
            gc[lane] = g; bu[lane] = be; bw[lane] = -be * __expf(g); tl[lane] = __expf(gl - g);
            if (lane == 0) EGL[ch] = __expf(gl);
        }
        LFENCE();
        {
#pragma unroll
            for (int t = 0; t < 3; ++t) { const int ib = t == 0 ? 0 : 1, jb = t == 2 ? 1 : 0;
                asm volatile("" ::: "memory");
                f32x16 x;
#pragma unroll
                for (int i = 0; i < 16; ++i) x[i] = 0.f;
#pragma unroll
                for (int ks = 0; ks < 8; ++ks) { const bf16x8 ka = *(const bf16x8*)(DK + (m0 + 32 * ib + r32) * 1024 + h * 128 + 16 * ks + 8 * hi), kb = *(const bf16x8*)(DK + (m0 + 32 * jb + r32) * 1024 + h * 128 + 16 * ks + 8 * hi);
                    x = MFMA32(ka, kb, x); }
                const int j = 32 * jb + r32; const float gcj = gc[j];
#pragma unroll
                for (int r = 0; r < 16; ++r) { const int i = 32 * ib + crow(r, hi); Lm[i * 68 + j] = (j < i) ? bu[i] * x[r] * __expf(gc[i] - gcj) : 0.f; }
            }
#pragma unroll
            for (int r = 0; r < 16; ++r) Lm[crow(r, hi) * 68 + 32 + r32] = 0.f;
#pragma unroll
            for (int t = 0; t < 3; ++t) { const int jb = t == 2 ? 1 : 0, ib = t == 0 ? 0 : 1;
                asm volatile("" ::: "memory");
                f32x16 x;
#pragma unroll
                for (int q = 0; q < 16; ++q) x[q] = 0.f;
#pragma unroll
                for (int ks = 0; ks < 8; ++ks) { const bf16x8 ka = *(const bf16x8*)(DK + (m0 + 32 * jb + r32) * 1024 + h * 128 + 16 * ks + 8 * hi), qb = *(const bf16x8*)(DQ + (m0 + 32 * ib + r32) * 1024 + h * 128 + 16 * ks + 8 * hi);
                    x = MFMA32(ka, qb, x); }
                const int i = 32 * ib + r32; const float gci = gc[i];
#pragma unroll
                for (int r = 0; r < 16; ++r) { const int j = 32 * jb + crow(r, hi); x[r] = (j <= i) ? x[r] * __expf(gci - gc[j]) : 0.f; }
                store_raw(ws + O_INTRA + (size_t)ch * 6144 + t * 2048 + lane * 32, x);
            }
        }
        LFENCE();
        {
            float t[64];
            t[0] = (lane == 0) ? 1.f : 0.f;
#pragma unroll
            for (int i = 1; i < 64; ++i) {
                float a0 = 0.f, a1 = 0.f, a2 = 0.f, a3 = 0.f;
#pragma unroll
                for (int j = 0; j < i; j += 4) { const f32x4 l4 = *(const LAS f32x4*)(Lm + i * 68 + j);
                    a0 += l4[0] * t[j]; if (j + 1 < i) a1 += l4[1] * t[j + 1]; if (j + 2 < i) a2 += l4[2] * t[j + 2]; if (j + 3 < i) a3 += l4[3] * t[j + 3]; }
                t[i] = ((lane == i) ? 1.f : 0.f) - ((a0 + a1) + (a2 + a3));
            }
            LFENCE();
#pragma unroll
            for (int i = 0; i < 64; ++i) Lm[i * 68 + lane] = t[i];
        }
        LFENCE();
        bf16x8 Tu[6], Tw[6];
#pragma unroll
        for (int q = 0; q < 6; ++q) { const int ib = q < 2 ? 0 : 1, s = q < 2 ? q : q - 2; const int i = 32 * ib + r32;
            const LAS float* tp = Lm + i * 68 + 16 * s + 8 * hi; const f32x4 t0 = *(const LAS f32x4*)tp, t1 = *(const LAS f32x4*)(tp + 4);
            const f32x4 u0 = *(const LAS f32x4*)(bu + 16 * s + 8 * hi), u1 = *(const LAS f32x4*)(bu + 16 * s + 8 * hi + 4);
            const f32x4 w0 = *(const LAS f32x4*)(bw + 16 * s + 8 * hi), w1 = *(const LAS f32x4*)(bw + 16 * s + 8 * hi + 4);
            const f32x4 a0 = t0 * u0, a1 = t1 * u1, c0 = t0 * w0, c1 = t1 * w1;
            u32x4 pu, pw; pu.x = pk2(a0[0], a0[1]); pu.y = pk2(a0[2], a0[3]); pu.z = pk2(a1[0], a1[1]); pu.w = pk2(a1[2], a1[3]);
            pw.x = pk2(c0[0], c0[1]); pw.y = pk2(c0[2], c0[3]); pw.z = pk2(c1[0], c1[1]); pw.w = pk2(c1[2], c1[3]);
            Tu[q] = __builtin_bit_cast(bf16x8, pu); Tw[q] = __builtin_bit_cast(bf16x8, pw); }
        const float tli = tl[r32], tli1 = tl[32 + r32], eg0 = __expf(gc[r32]), eg1 = __expf(gc[32 + r32]);
        LFENCE();
#pragma unroll 4
        for (int it = 0; it < 16; ++it) { const int idx = it * 64 + lane, row = idx >> 4, c16 = idx & 15;
            *(LAS u32x4*)(base + row * 272 + c16 * 16) = *(const u32x4*)(DV + (m0 + row) * 1024 + h * 128 + c16 * 8); }
        LFENCE();
        lptr vb = base + (8 * hi + ((lane & 15) >> 2)) * 272 + (((lane >> 4) & 1) * 16 + (lane & 3) * 4) * 2;
#pragma unroll 1
        for (int eb = 0; eb < 4; ++eb) {
            bf16x8 vf[4];
#pragma unroll
            for (int s = 0; s < 4; ++s) { const s16x4 lo = vtr(vb + 16 * s * 272 + eb * 64), hh = vtr(vb + (16 * s + 4) * 272 + eb * 64); vf[s] = __builtin_shufflevector(lo, hh, 0, 1, 2, 3, 4, 5, 6, 7); }
#pragma unroll
            for (int ib = 0; ib < 2; ++ib) { f32x16 x;
#pragma unroll
                for (int i = 0; i < 16; ++i) x[i] = 0.f;
#pragma unroll
                for (int s = 0; s < 4; ++s) if (ib == 1 || s < 2) x = MFMA32(Tu[ib == 0 ? s : 2 + s], vf[s], x);
                store_raw(rawp(ws + O_DV, m0, h, (eb * 2 + ib) * 2048 + lane * 32), x); }
        }
        LFENCE();
#pragma unroll 4
        for (int it = 0; it < 16; ++it) { const int idx = it * 64 + lane, row = idx >> 4, c16 = idx & 15;
            *(LAS u32x4*)(base + row * 272 + c16 * 16) = *(const u32x4*)(DK + (m0 + row) * 1024 + h * 128 + c16 * 8); }
        LFENCE();
#pragma unroll 1
        for (int dkb = 0; dkb < 4; ++dkb) {
            bf16x8 kf[4];
#pragma unroll
            for (int s = 0; s < 4; ++s) { const s16x4 lo = vtr(vb + 16 * s * 272 + dkb * 64), hh = vtr(vb + (16 * s + 4) * 272 + dkb * 64); kf[s] = __builtin_shufflevector(lo, hh, 0, 1, 2, 3, 4, 5, 6, 7); }
#pragma unroll
            for (int ib = 0; ib < 2; ++ib) { f32x16 x;
#pragma unroll
                for (int i = 0; i < 16; ++i) x[i] = 0.f;
#pragma unroll
                for (int s = 0; s < 4; ++s) if (ib == 1 || s < 2) x = MFMA32(kf[s], Tw[ib == 0 ? s : 2 + s], x);
                store_raw(ws + O_WT + (size_t)ch * 16384 + (dkb * 2 + ib) * 2048 + lane * 32, x); }
#pragma unroll
            for (int ib = 0; ib < 2; ++ib) { f32x16 x;
#pragma unroll
                for (int i = 0; i < 16; ++i) x[i] = 0.f;
                const unsigned tb = f2bf(ib ? tli1 : tli);
#pragma unroll
                for (int t = 0; t < 2; ++t) { const int rel = r32 - 16 * t - 8 * hi;
                    u32x4 d; d.x = (rel == 0 ? tb : 0u) | (rel == 1 ? tb << 16 : 0u); d.y = (rel == 2 ? tb : 0u) | (rel == 3 ? tb << 16 : 0u);
                    d.z = (rel == 4 ? tb : 0u) | (rel == 5 ? tb << 16 : 0u); d.w = (rel == 6 ? tb : 0u) | (rel == 7 ? tb << 16 : 0u);
                    x = MFMA32(__builtin_bit_cast(bf16x8, d), kf[2 * ib + t], x); }
                store_raw(rawp((unsigned char*)DQ + (size_t)M * 2048, m0, h, (ib * 4 + dkb) * 2048 + lane * 32), x); }
        }
        LFENCE();
#pragma unroll 4
        for (int it = 0; it < 16; ++it) { const int idx = it * 64 + lane, row = idx >> 4, c16 = idx & 15;
            *(LAS u32x4*)(base + row * 272 + c16 * 16) = *(const u32x4*)(DQ + (m0 + row) * 1024 + h * 128 + c16 * 8); }
        asm volatile("s_waitcnt vmcnt(0) lgkmcnt(0)" ::: "memory");
#pragma unroll
        for (int blk = 0; blk < 8; ++blk) { const int dkb = blk >> 1, ib = blk & 1; const float e = ib ? eg1 : eg0;
            lptr qp = base + (32 * ib + r32) * 272 + (32 * dkb + 4 * hi) * 2;
            u32x2 q0 = *(const LAS u32x2*)qp, q1 = *(const LAS u32x2*)(qp + 16), q2 = *(const LAS u32x2*)(qp + 32), q3 = *(const LAS u32x2*)(qp + 48);
            u32x4 lo, hh;
            lo.x = pk2(bflo(q0.x) * e, bfhi(q0.x) * e); lo.y = pk2(bflo(q0.y) * e, bfhi(q0.y) * e); lo.z = pk2(bflo(q1.x) * e, bfhi(q1.x) * e); lo.w = pk2(bflo(q1.y) * e, bfhi(q1.y) * e);
            hh.x = pk2(bflo(q2.x) * e, bfhi(q2.x) * e); hh.y = pk2(bflo(q2.y) * e, bfhi(q2.y) * e); hh.z = pk2(bflo(q3.x) * e, bfhi(q3.x) * e); hh.w = pk2(bflo(q3.y) * e, bfhi(q3.y) * e);
            const int o = blk * 2048 + lane * 32;
            unsigned char* dst = (unsigned char*)DQ + (m0 + (o >> 8)) * 2048 + h * 256 + (o & 255);
            *(u32x4*)dst = lo; *(u32x4*)(dst + 16) = hh; }
    }
}
DI void unpack16(f32x16& x, const unsigned char* p) { const u32x4 a = *(const u32x4*)p, b = *(const u32x4*)(p + 16);
    x[0] = bflo(a.x); x[1] = bfhi(a.x); x[2] = bflo(a.y); x[3] = bfhi(a.y); x[4] = bflo(a.z); x[5] = bfhi(a.z); x[6] = bflo(a.w); x[7] = bfhi(a.w);
    x[8] = bflo(b.x); x[9] = bfhi(b.x); x[10] = bflo(b.y); x[11] = bfhi(b.y); x[12] = bflo(b.z); x[13] = bfhi(b.z); x[14] = bflo(b.w); x[15] = bfhi(b.w); }
DI void delta_B2(const Params& P, unsigned char* lds_, int bh) {
    lptr lds = (lptr)lds_;
    constexpr int BUF = 55296;
    unsigned char* ws = P.ws;
    const int tid = threadIdx.x, lane = tid & 63, wid = __builtin_amdgcn_readfirstlane(tid >> 6);
    const int b = bh >> 3, h = bh & 7;
    unsigned char* dq = (unsigned char*)P.out; unsigned char* dk = dq + (size_t)M * 2048; unsigned char* dv = ws + O_DV;
    __syncthreads();
    if (wid >= 4) {
        const int tl = tid - 256;
        u32x4 ra[14], rb[14];
#define DB_LD(n, r) do { const int ch_ = (b * 64 + (n)) * 8 + h; const size_t m0_ = (size_t)b * S + 64 * (n); \
        _Pragma("unroll") for (int j = 0; j < 14; ++j) { const int idx = tl + 256 * j; if (j < 13 || tl < 128) { const unsigned char* s_; \
            if (j < 4) s_ = ws + O_WT + (size_t)ch_ * 16384 + idx * 16; \
            else if (j < 8) s_ = rawp(dq, m0_, h, (idx - 1024) * 16); \
            else if (j < 12) s_ = rawp(dk, m0_, h, (idx - 2048) * 16); \
            else s_ = ws + O_INTRA + (size_t)ch_ * 6144 + (idx - 3072) * 16; \
            r[j] = *(const u32x4*)s_; } } } while (0)
#define DB_ST(bufi, r) do { _Pragma("unroll") for (int j = 0; j < 14; ++j) { const int idx = tl + 256 * j; if (j < 13 || tl < 128) *(LAS u32x4*)(lds + (bufi) * BUF + idx * 16) = r[j]; } } while (0)
        DB_LD(0, ra); DB_LD(1, rb); DB_ST(0, ra); DB_LD(2, ra);
        __syncthreads();
        for (int n = 0; n < 64; n += 2) {
            DB_ST(1, rb); if (n + 3 < 64) DB_LD(n + 3, rb);
            __syncthreads();
            if (n + 2 < 64) { DB_ST(0, ra); if (n + 4 < 64) DB_LD(n + 4, ra); }
            __syncthreads();
        }
#undef DB_LD
#undef DB_ST
    } else {
        const int eb = wid;
        const float* EGL = (const float*)(ws + O_EGL);
        f32x16 St[4];
#pragma unroll
        for (int d = 0; d < 4; ++d)
#pragma unroll
            for (int i = 0; i < 16; ++i) St[d][i] = 0.f;
        u32x4 up[4];
        { unsigned char* u0 = rawp(dv, (size_t)b * S, h, (eb * 2) * 2048 + lane * 32), *u1 = rawp(dv, (size_t)b * S, h, (eb * 2 + 1) * 2048 + lane * 32);
          up[0] = *(const u32x4*)u0; up[1] = *(const u32x4*)(u0 + 16); up[2] = *(const u32x4*)u1; up[3] = *(const u32x4*)(u1 + 16); }
        __syncthreads();
        for (int n = 0; n < 64; ++n) {
            const int ch = (b * 64 + n) * 8 + h; const size_t m0 = (size_t)b * S + 64 * n;
            lptr bf = lds + (n & 1) * BUF + lane * 32;
            const float eg = EGL[ch];
            f32x16 vn[2], ob[2];
#pragma unroll
            for (int ib = 0; ib < 2; ++ib) { const u32x4 a = up[2 * ib], c = up[2 * ib + 1];
                vn[ib][0] = bflo(a.x); vn[ib][1] = bfhi(a.x); vn[ib][2] = bflo(a.y); vn[ib][3] = bfhi(a.y); vn[ib][4] = bflo(a.z); vn[ib][5] = bfhi(a.z); vn[ib][6] = bflo(a.w); vn[ib][7] = bfhi(a.w);
                vn[ib][8] = bflo(c.x); vn[ib][9] = bfhi(c.x); vn[ib][10] = bflo(c.y); vn[ib][11] = bfhi(c.y); vn[ib][12] = bflo(c.z); vn[ib][13] = bfhi(c.z); vn[ib][14] = bflo(c.w); vn[ib][15] = bfhi(c.w); }
            unsigned char* o0 = rawp(dv, m0, h, (eb * 2) * 2048 + lane * 32); unsigned char* o1 = rawp(dv, m0, h, (eb * 2 + 1) * 2048 + lane * 32);
            if (n + 1 < 64) { const unsigned char* u0 = rawp(dv, m0 + 64, h, (eb * 2) * 2048 + lane * 32); const unsigned char* u1 = rawp(dv, m0 + 64, h, (eb * 2 + 1) * 2048 + lane * 32);
                up[0] = *(const u32x4*)u0; up[1] = *(const u32x4*)(u0 + 16); up[2] = *(const u32x4*)u1; up[3] = *(const u32x4*)(u1 + 16); }
            bf16x8 Spk[8];
#pragma unroll
            for (int s = 0; s < 8; ++s) Spk[s] = pack8(St[s >> 1], 8 * (s & 1));
#pragma unroll
            for (int i = 0; i < 16; ++i) { ob[0][i] = 0.f; ob[1][i] = 0.f; }
#pragma unroll
            for (int s = 0; s < 8; ++s)
#pragma unroll
                for (int ib = 0; ib < 2; ++ib) { const int o = ((s >> 1) * 2 + ib) * 2048 + 16 * (s & 1);
                    vn[ib] = MFMA32(*(const LAS bf16x8*)(bf + o), Spk[s], vn[ib]);
                    ob[ib] = MFMA32(*(const LAS bf16x8*)(bf + 16384 + o), Spk[s], ob[ib]); }
            bf16x8 vpk[2][2];
#pragma unroll
            for (int ib = 0; ib < 2; ++ib) { vpk[ib][0] = pack8(vn[ib], 0); vpk[ib][1] = pack8(vn[ib], 8); }
#pragma unroll
            for (int t = 0; t < 2; ++t) {
                ob[0] = MFMA32(*(const LAS bf16x8*)(bf + 49152 + 0 * 2048 + 16 * t), vpk[0][t], ob[0]);
                ob[1] = MFMA32(*(const LAS bf16x8*)(bf + 49152 + 1 * 2048 + 16 * t), vpk[0][t], ob[1]);
                ob[1] = MFMA32(*(const LAS bf16x8*)(bf + 49152 + 2 * 2048 + 16 * t), vpk[1][t], ob[1]);
            }
            store_raw(o0, ob[0]); store_raw(o1, ob[1]);
#pragma unroll
            for (int dkb = 0; dkb < 4; ++dkb) { St[dkb] = St[dkb] * eg;
#pragma unroll
                for (int s = 0; s < 4; ++s) St[dkb] = MFMA32(*(const LAS bf16x8*)(bf + 32768 + ((s >> 1) * 4 + dkb) * 2048 + 16 * (s & 1)), vpk[s >> 1][s & 1], St[dkb]); }
            __syncthreads();
        }
    }
    __syncthreads();
}

DI void p9_normgate(const Params& P, int gw, int ngw, int lane) {
    unsigned char* ws = P.ws;
    const bf16_t* Z = (const bf16_t*)(ws + O_Z); bf16_t* OG = (bf16_t*)P.out + (size_t)M * 1024;
    const int r32 = lane & 31, hi = lane >> 5;
    for (int ch = gw; ch < 2048; ch += ngw) {
        const int h = ch & 7, bn = ch >> 3, b = bn >> 6, n = bn & 63; const size_t m0 = (size_t)b * S + 64 * n;
#pragma unroll 1
        for (int ib = 0; ib < 2; ++ib) {
            f32x16 o[4]; float ss[16];
#pragma unroll
            for (int eb = 0; eb < 4; ++eb) unpack16(o[eb], rawp(ws + O_DV, m0, h, (eb * 2 + ib) * 2048 + lane * 32));
#pragma unroll
            for (int r = 0; r < 16; ++r) { float s = o[0][r] * o[0][r] + o[1][r] * o[1][r] + o[2][r] * o[2][r] + o[3][r] * o[3][r];
                s += __shfl_xor(s, 1); s += __shfl_xor(s, 2); s += __shfl_xor(s, 4); s += __shfl_xor(s, 8); s += __shfl_xor(s, 16);
                ss[r] = rsqrtf(s * (1.f / 128.f) + 1e-6f); }
            const size_t rb_ = (m0 + 32 * ib + 4 * hi) * 1024 + h * 128 + r32;
#pragma unroll
            for (int eb = 0; eb < 4; ++eb) { const float w = P.dn_norm_w[32 * eb + r32];
                const bf16_t* zp = Z + rb_ + 32 * eb; bf16_t* op = OG + rb_ + 32 * eb;
#pragma unroll
                for (int g = 0; g < 4; ++g) {
#pragma unroll
                    for (int q = 0; q < 4; ++q) { const int r = 4 * g + q; op[(8 * g + q) * 1024] = (bf16_t)f2bf(o[eb][r] * ss[r] * w * silu(bf2f(zp[(8 * g + q) * 1024]))); }
                    asm volatile("" ::: "memory");
                } }
        }
    }
}
DI void ln_rows(const float* __restrict__ in, float* __restrict__ outf, bf16_t* __restrict__ outb, const float* g, const float* bta, int gw, int ngw, int lane) {
    for (int m = gw; m < M; m += ngw) {
        const f32x4* xr = (const f32x4*)(in + (size_t)m * D) + lane;
        f32x4 v[4]; float s = 0.f;
#pragma unroll
        for (int j = 0; j < 4; ++j) { v[j] = xr[64 * j]; s += (v[j][0] + v[j][1]) + (v[j][2] + v[j][3]); }
        const float mean = wave_sum(s) * (1.f / D); float s2 = 0.f;
#pragma unroll
        for (int j = 0; j < 4; ++j) { v[j] = v[j] - mean; s2 += (v[j][0] * v[j][0] + v[j][1] * v[j][1]) + (v[j][2] * v[j][2] + v[j][3] * v[j][3]); }
        const float rstd = rsqrtf(wave_sum(s2) * (1.f / D) + 1e-5f);
#pragma unroll
        for (int j = 0; j < 4; ++j) { const int c = 4 * lane + 256 * j; const f32x4 gg = *(const f32x4*)(g + c), bb = *(const f32x4*)(bta + c); const f32x4 o = v[j] * rstd * gg + bb;
            *(f32x4*)(outf + (size_t)m * D + c) = o; if (outb) st4(outb + (size_t)m * D + c, o); }
    }
}

DI void grid_barrier(unsigned* cnt, unsigned& k, unsigned G) {
    asm volatile("s_waitcnt vmcnt(0) lgkmcnt(0)" ::: "memory");
    __syncthreads();
    if (threadIdx.x == 0) {
        __builtin_amdgcn_fence(__ATOMIC_RELEASE, "agent");
        asm volatile("s_waitcnt vmcnt(0)" ::: "memory");
        __hip_atomic_fetch_add(cnt, 1u, __ATOMIC_RELAXED, __HIP_MEMORY_SCOPE_AGENT);
        const unsigned target = (k + 1u) * G;
        while (__hip_atomic_load(cnt, __ATOMIC_RELAXED, __HIP_MEMORY_SCOPE_AGENT) < target) __builtin_amdgcn_s_sleep(1);
        __builtin_amdgcn_fence(__ATOMIC_ACQUIRE, "agent");
        asm volatile("s_waitcnt vmcnt(0)" ::: "memory");
    }
    ++k;
    __syncthreads();
}

constexpr int NPH = 13;
__global__ void __launch_bounds__(NTHREADS, 2) mega(Params P) {
    extern __shared__ __attribute__((aligned(16))) unsigned char lds[];
    cg::grid_group grid = cg::this_grid();
    const int tid = threadIdx.x, lane = tid & 63, wid = tid >> 6;
    const int gw = blockIdx.x * NWAVES + wid, ngw = gridDim.x * NWAVES;
    const size_t gt = (size_t)blockIdx.x * NTHREADS + tid, ngt = (size_t)gridDim.x * NTHREADS;
    unsigned char* ws = P.ws;
    bf16_t* WIN = (bf16_t*)(ws + W_IN);
    bf16_t* XB = (bf16_t*)P.out;
    unsigned* barcnt = (unsigned*)(ws + O_BAR); unsigned bark = 0;
#define PH_BEGIN(k) if (P.ph_lo <= (k) && (k) < P.ph_hi) {
#define PH_END(k) if ((k) + 1 < P.ph_hi) { if (P.ph_hi > 1000) grid.sync(); else grid_barrier(barcnt, bark, gridDim.x); } }
    PH_BEGIN(0) {
            cvt_rows(P.x, XB, (size_t)M * D / 8, gt, ngt);
            transpose_mat(P.w_in, 1024, 6864, WIN, NA, 1, gw, ngw, lane, lds);
        } PH_END(0)
    PH_BEGIN(1) { EpiProjA E{(bf16_t*)(ws + O_PROJA), (float*)(ws + O_AB)}; gemm_run(lds, XB, 1024, WIN, 1024, M, NA, 1024, E); } PH_END(1)
    PH_BEGIN(2) { p2_tokens(P, gw, ngw, lane);
            __syncthreads();
            transpose_rest(P, gw, ngw, lane, lds);
        } PH_END(2)
    PH_BEGIN(3) { delta_A(P, lds, gw, ngw, lane, wid);
                  __syncthreads();
                  { EpiQ E{(bf16_t*)(ws + O_Q)}; gemm_run(lds, (const bf16_t*)(ws + O_CQ), 384, (const bf16_t*)(ws + W_UQ), 384, M, 1536, 384, E); }
                  { EpiKV E{(bf16_t*)(ws + O_KN), (bf16_t*)(ws + O_V)}; gemm_run(lds, (const bf16_t*)(ws + O_CKV), 256, (const bf16_t*)(ws + W_UKV), 256, M, 2048, 256, E); } } PH_END(3)
    PH_BEGIN(4) {
        unsigned* ctl = (unsigned*)(ws + O_BAR);
        if (blockIdx.x < 32) { for (int u = blockIdx.x; u < 32; u += gridDim.x) delta_B2(P, lds, u);
            if (tid == 0) { asm volatile("s_waitcnt vmcnt(0)" ::: "memory"); __hip_atomic_fetch_add(ctl + 64 * 9, gridDim.x < 32 ? 32u / gridDim.x : 1u, __ATOMIC_RELEASE, __HIP_MEMORY_SCOPE_AGENT); } }
        attn_queue(P, lds, ctl + 64);
        if (tid == 0) { const unsigned want = gridDim.x < 32 ? (32u / gridDim.x) * gridDim.x : 32u; while (__hip_atomic_load(ctl + 64 * 9, __ATOMIC_RELAXED, __HIP_MEMORY_SCOPE_AGENT) < want) __builtin_amdgcn_s_sleep(2); }
        __syncthreads();
        cvt_rows(P.x, XB, (size_t)M * D / 8, gt, ngt);
    } PH_END(4)
    PH_BEGIN(5) { EpiZG E{(bf16_t*)(ws + O_Z), (bf16_t*)(ws + O_GD), (bf16_t*)(ws + O_GM)}; gemm_run(lds, XB, 1024, WIN + (size_t)NA * 1024, 1024, M, NB, 1024, E); } PH_END(5)
    PH_BEGIN(6) p9_normgate(P, gw, ngw, lane); PH_END(6)
    PH_BEGIN(7) { { EpiYdn E{(bf16_t*)(ws + O_GD)}; gemm_run(lds, (const bf16_t*)P.out + (size_t)M * 1024, 1024, (const bf16_t*)(ws + W_BRDN), 1024, M, 1024, 1024, E); }
                  asm volatile("s_waitcnt vmcnt(0)" ::: "memory");
                  { EpiYmla E{(const bf16_t*)(ws + O_GD), (bf16_t*)(ws + O_GM)}; gemm_run(lds, (const bf16_t*)(ws + O_Q), 1536, (const bf16_t*)(ws + W_BRMLA), 1536, M, 1024, 1536, E); } } PH_END(7)
    PH_BEGIN(8) { EpiWo E{P.x, P.out}; gemm_run(lds, (const bf16_t*)(ws + O_GM), 1024, (const bf16_t*)(ws + W_O), 1024, M, 1024, 1024, E); } PH_END(8)
    PH_BEGIN(9) { ln_rows(P.out, (float*)(ws + O_H1), (bf16_t*)(ws + O_H1B), P.ln1_g, P.ln1_b, gw, ngw, lane);
                  cvt_rows(P.p, (bf16_t*)(ws + O_PB), (size_t)M * 256 / 8, gt, ngt); } PH_END(9)
    PH_BEGIN(10) { { EpiFfnIn E{(bf16_t*)(ws + O_ACT)}; gemm_run(lds, (const bf16_t*)(ws + O_H1B), 1024, (const bf16_t*)(ws + W_FFNIN), 1024, M, 5632, 1024, E); }
                   { EpiSg E{(bf16_t*)P.out}; gemm_run(lds, (const bf16_t*)(ws + O_H1B), 1024, (const bf16_t*)(ws + W_PG), 1024, M, 1024, 1024, E); }
                   { EpiStore E{(bf16_t*)P.out + (size_t)M * 1024, 1024}; gemm_run(lds, (const bf16_t*)(ws + O_PB), 256, (const bf16_t*)(ws + W_PLE), 256, M, 1024, 256, E); } } PH_END(10)
    PH_BEGIN(11) { EpiFfnOut E{(float*)(ws + O_H1), (const bf16_t*)P.out, (const bf16_t*)P.out + (size_t)M * 1024}; gemm_run(lds, (const bf16_t*)(ws + O_ACT), FF, (const bf16_t*)(ws + W_FFNOUT), FF, M, 1024, FF, E); } PH_END(11)
    PH_BEGIN(12) ln_rows((const float*)(ws + O_H1), P.out, nullptr, P.ln2_g, P.ln2_b, gw, ngw, lane); PH_END(12)
}

extern "C" void kernel_launch(void* const* d_in, const int* in_sizes, int n_in, void* d_out, int out_size, void* d_ws, size_t ws_size, hipStream_t stream) {
    static int grid = 0;
    if (grid == 0) {
        int dev = 0, cus = 0, per_cu = 0;
        (void)hipGetDevice(&dev);
        (void)hipDeviceGetAttribute(&cus, hipDeviceAttributeMultiprocessorCount, dev);
        (void)hipFuncSetAttribute((const void*)mega, hipFuncAttributeMaxDynamicSharedMemorySize, LDS_BYTES);
        (void)hipOccupancyMaxActiveBlocksPerMultiprocessor(&per_cu, (const void*)mega, NTHREADS, LDS_BYTES);
        if (per_cu < 1) per_cu = 1;
        grid = cus * per_cu;
        if (ws_size < 256 * MiB) { fprintf(stderr, "workspace too small: %zu\n", ws_size); grid = -1; }
    }
    if (grid < 0) return;
    (void)hipMemsetAsync((unsigned char*)d_ws + O_BAR, 0, 4096, stream);
    Params P{};
    const float** pf = (const float**)&P;
    for (int i = 0; i < 24; ++i) pf[i] = (const float*)d_in[i];
    P.out = (float*)d_out; P.ws = (unsigned char*)d_ws;
#if NLAUNCH == 1
    P.ph_lo = 0; P.ph_hi = NPH;
    { void* args[] = {&P}; hipError_t e = hipLaunchCooperativeKernel((const void*)mega, dim3(grid), dim3(NTHREADS), args, LDS_BYTES, stream);
      if (e != hipSuccess) fprintf(stderr, "cooperative launch failed: %s\n", hipGetErrorString(e)); }
#else
    for (int ph = 0; ph < NPH; ++ph) { P.ph_lo = ph; P.ph_hi = ph + 1; void* args[] = {&P};
        hipError_t e = hipLaunchCooperativeKernel((const void*)mega, dim3(grid), dim3(NTHREADS), args, LDS_BYTES, stream);
        if (e != hipSuccess) { fprintf(stderr, "cooperative launch failed: %s\n", hipGetErrorString(e)); break; } }
#endif
}
```

```cpp
#include <hip/hip_runtime.h>
#include <hip/hip_cooperative_groups.h>
#include <cstdint>
#include <cstdio>
namespace cg = cooperative_groups;

#define DI __device__ __forceinline__
typedef unsigned short bf16_t;
typedef short bf16x8 __attribute__((ext_vector_type(8)));
typedef float f32x4 __attribute__((ext_vector_type(4)));
typedef float f32x2 __attribute__((ext_vector_type(2)));
typedef unsigned u32x4 __attribute__((ext_vector_type(4)));
typedef unsigned u32x2 __attribute__((ext_vector_type(2)));

#ifndef NLAUNCH
#define NLAUNCH 1
#endif

constexpr int Bn = 4, S = 4096, D = 1024, M = Bn * S;
constexpr int NA = 3840, NB = 3072, NIN = NA + NB;
constexpr int FF = 2816;
constexpr int NTHREADS = 512, NWAVES = 8;
constexpr int LDS_BYTES = 147456 + 64;
constexpr float ALPHA = 1.189207115002721f;
constexpr float C2 = 0.07216878364870322f * 1.4426950408889634f;

constexpr size_t MiB = 1u << 20;
constexpr size_t W_IN = 0, W_UQ = W_IN + (size_t)NIN * 1024 * 2, W_UKV = W_UQ + (size_t)1536 * 384 * 2, W_BRDN = W_UKV + (size_t)2048 * 256 * 2,
                 W_BRMLA = W_BRDN + 2 * MiB, W_O = W_BRMLA + 3 * MiB, W_FFNIN = W_O + 2 * MiB, W_FFNOUT = W_FFNIN + (size_t)5632 * 1024 * 2,
                 W_PG = W_FFNOUT + (size_t)1024 * FF * 2, W_PLE = W_PG + 2 * MiB, W_END = W_PLE + (size_t)1024 * 256 * 2;
static_assert(W_END <= 41 * MiB + 768 * 1024, "weights");
constexpr size_t O_BAR = 41 * MiB + 768 * 1024;
constexpr size_t O_AB = 42 * MiB, O_EGL = O_AB, O_BETA = 43 * MiB, O_GG = 43 * MiB + MiB / 2, O_CQ = 44 * MiB, O_PB = O_CQ, O_CKV = 56 * MiB, O_KR = 64 * MiB;
constexpr size_t ARENA = 66 * MiB;
constexpr size_t O_PROJA = ARENA, O_DV = 224 * MiB;
constexpr size_t O_WT = ARENA, O_INTRA = ARENA + 32 * MiB, O_Q = ARENA + 44 * MiB, O_KN = ARENA + 92 * MiB, O_V = ARENA + 124 * MiB;
constexpr size_t O_Z = ARENA, O_GD = O_KN, O_GM = O_V;
constexpr size_t O_H1 = ARENA, O_H1B = ARENA + 64 * MiB, O_ACT = ARENA + 96 * MiB;
static_assert(O_V + 32 * MiB <= O_DV && O_PROJA + 120 * MiB <= O_DV && O_ACT + 88 * MiB <= 256 * MiB && O_DV + 32 * MiB <= 256 * MiB, "ws map");

struct Params {
    const float* x; const float* p; const int* pos; const float* w_in; const float* conv_w; const float* a_log; const float* dt_bias; const float* dn_norm_w;
    const float* q_norm_w; const float* w_uq; const float* kv_norm_w; const float* w_uk; const float* w_uv; const float* w_br_dn; const float* w_br_mla; const float* w_o;
    const float* ln1_g; const float* ln1_b; const float* w_ffn_in; const float* w_ffn_out; const float* w_ple; const float* w_ple_gate; const float* ln2_g; const float* ln2_b;
    float* out; unsigned char* ws; int ph_lo, ph_hi;
};

DI unsigned f2bf(float f) { unsigned u = __float_as_uint(f); return (u + 0x7fffu + ((u >> 16) & 1u)) >> 16; }
typedef __bf16 bf16x2_t __attribute__((ext_vector_type(2)));
DI unsigned pk2(float lo, float hi) { const f32x2 v = {lo, hi}; return __builtin_bit_cast(unsigned, __builtin_convertvector(v, bf16x2_t)); }
DI float bflo(unsigned u) { return __uint_as_float(u << 16); }
DI float bfhi(unsigned u) { return __uint_as_float(u & 0xffff0000u); }
DI float bf2f(bf16_t b) { return __uint_as_float(((unsigned)b) << 16); }
DI float sigm(float x) { return 1.f / (1.f + __expf(-x)); }
DI float silu(float x) { return x / (1.f + __expf(-x)); }
DI float wave_sum(float v) {
#pragma unroll
    for (int o = 1; o < 64; o <<= 1) v += __shfl_xor(v, o);
    return v;
}
DI float wave_max(float v) {
#pragma unroll
    for (int o = 1; o < 64; o <<= 1) v = fmaxf(v, __shfl_xor(v, o));
    return v;
}
DI void st4(bf16_t* p, f32x4 v) { u32x2 w; w.x = pk2(v[0], v[1]); w.y = pk2(v[2], v[3]); *(u32x2*)p = w; }
DI f32x4 ld4(const bf16_t* p) { const u32x2 w = *(const u32x2*)p; return (f32x4){bflo(w.x), bfhi(w.x), bflo(w.y), bfhi(w.y)}; }
DI void rope_cs(int pos, int i, float& c, float& s) {
    const float inv = exp2f(-(float)i * (13.287712379549449f / 32.f));
    const float ang = (float)pos * inv;
    const double a = (double)ang; const double k = rint(a * 0.15915494309189535); const float r = (float)(a - k * 6.283185307179586);
    c = __cosf(r); s = __sinf(r);
}

DI void transpose_item(const float* __restrict__ W, int K, int ldw, bf16_t* __restrict__ WT, int mode, int it, int lane, unsigned char* lds_) {
    typedef __attribute__((address_space(3))) float lfloat;
    lfloat* scr = (lfloat*)((__attribute__((address_space(3))) unsigned char*)lds_ + (threadIdx.x >> 6) * 8448);
    const int nkb = K / 64;
    {
        const int nb = it / nkb, kb = it % nkb, n = nb * 32 + (lane & 31), k0 = kb * 64;
        int sc = n;
        if (mode == 1) { if (n < 3072) sc = n; else if (n < 3792) sc = n + 1024; else if (n < 3840) sc = -1; else { const int nn = n - 3840; sc = nn < 1024 ? nn + 3072 : nn + 3792; } }
        else if (mode == 6) { sc = n < 1024 ? n + 3072 : n + 3792; }
        else if (mode == 3) { const int t = n >> 8, w = n & 255; sc = w < 128 ? 128 * t + w : 2816 + 128 * t + (w - 128); }
        else if (mode == 4) { const int h = n / 192, d = n % 192; if (d >= 128) { const int r = d - 128; sc = h * 192 + 128 + (r >> 1) + 32 * (r & 1); } }
        int kr = k0; if (mode == 5) { const int hh = kb / 3, part = kb % 3; kr = hh * 128 + part * 64; if (part == 2) sc = -1; }
#pragma unroll 16
        for (int i = 0; i < 32; ++i) { const int kk = 2 * i + (lane >> 5); scr[kk * 33 + (lane & 31)] = sc >= 0 ? W[(size_t)(kr + kk) * ldw + sc] : 0.f; }
        asm volatile("s_waitcnt lgkmcnt(0)" ::: "memory");
        const int c = lane & 7;
#pragma unroll
        for (int j = 0; j < 4; ++j) { const int nn = (lane >> 3) + 8 * j; const lfloat* s = scr + (8 * c) * 33 + nn;
            u32x4 o; o.x = pk2(s[0 * 33], s[1 * 33]); o.y = pk2(s[2 * 33], s[3 * 33]); o.z = pk2(s[4 * 33], s[5 * 33]); o.w = pk2(s[6 * 33], s[7 * 33]);
            *(u32x4*)(WT + (size_t)(nb * 32 + nn) * K + k0 + 8 * c) = o; }
        asm volatile("s_waitcnt lgkmcnt(0)" ::: "memory");
    }
}
DI void transpose_mat(const float* __restrict__ W, int K, int ldw, bf16_t* __restrict__ WT, int nrows, int mode, int gw, int ngw, int lane, unsigned char* lds_) {
    const int nitems = (nrows / 32) * (K / 64);
    for (int it = gw; it < nitems; it += ngw) transpose_item(W, K, ldw, WT, mode, it, lane, lds_);
}
DI void transpose_rest(const Params& P, int gw, int ngw, int lane, unsigned char* lds_) {
    unsigned char* ws = P.ws;
    constexpr int I0 = (1536 / 32) * (384 / 64), I1 = I0 + 2 * (1024 / 32) * (256 / 64), I2 = I1 + (NB / 32) * 16, I3 = I2 + 32 * 16, I4 = I3 + 32 * 24, I5 = I4 + 32 * 16,
                  I6 = I5 + (5632 / 32) * 16, I7 = I6 + 32 * (FF / 64), I8 = I7 + 32 * 16, I9 = I8 + 32 * 4;
    for (int g = gw; g < I9; g += ngw) {
        if (g < I0) transpose_item(P.w_uq, 384, 1536, (bf16_t*)(ws + W_UQ), 4, g, lane, lds_);
        else if (g < I1) { const int q = g - I0; if (q < 128) transpose_item(P.w_uk, 256, 1024, (bf16_t*)(ws + W_UKV), 0, q, lane, lds_); else transpose_item(P.w_uv, 256, 1024, (bf16_t*)(ws + W_UKV) + (size_t)1024 * 256, 0, q - 128, lane, lds_); }
        else if (g < I2) transpose_item(P.w_in, 1024, 6864, (bf16_t*)(ws + W_IN) + (size_t)NA * 1024, 6, g - I1, lane, lds_);
        else if (g < I3) transpose_item(P.w_br_dn, 1024, 1024, (bf16_t*)(ws + W_BRDN), 0, g - I2, lane, lds_);
        else if (g < I4) transpose_item(P.w_br_mla, 1536, 1024, (bf16_t*)(ws + W_BRMLA), 5, g - I3, lane, lds_);
        else if (g < I5) transpose_item(P.w_o, 1024, 1024, (bf16_t*)(ws + W_O), 0, g - I4, lane, lds_);
        else if (g < I6) transpose_item(P.w_ffn_in, 1024, 5632, (bf16_t*)(ws + W_FFNIN), 3, g - I5, lane, lds_);
        else if (g < I7) transpose_item(P.w_ffn_out, FF, 1024, (bf16_t*)(ws + W_FFNOUT), 0, g - I6, lane, lds_);
        else if (g < I8) transpose_item(P.w_ple_gate, 1024, 1024, (bf16_t*)(ws + W_PG), 0, g - I7, lane, lds_);
        else transpose_item(P.w_ple, 256, 1024, (bf16_t*)(ws + W_PLE), 0, g - I8, lane, lds_);
    }
}
DI void cvt_rows(const float* __restrict__ src, bf16_t* __restrict__ dst, size_t n8, size_t gt, size_t ngt) {
#pragma unroll 4
    for (size_t i = gt; i < n8; i += ngt) { const f32x4 a = *(const f32x4*)(src + i * 8), b = *(const f32x4*)(src + i * 8 + 4);
        u32x4 o; o.x = pk2(a[0], a[1]); o.y = pk2(a[2], a[3]); o.z = pk2(b[0], b[1]); o.w = pk2(b[2], b[3]); *(u32x4*)(dst + i * 8) = o; }
}

namespace pg8 {
#define PG8_LAS __attribute__((address_space(3)))
constexpr int BM = 256, BK = 64, HALF = 128, HTB = HALF * BK * 2, STAGE_BYTES = 8 * HTB, NXCD = 8, WGM = 8;
DI int lds_byte(int r, int c) { const int st = (r >> 4) * 2 + (c >> 5), rr = r & 15, cc = c & 31, ob = rr * 64 + cc * 2; return st * 1024 + (ob ^ (((ob >> 9) & 1) << 5)); }
DI void stage_rc(int b, int& R, int& C) { const int st = b / 1024, sb = b % 1024, swz = sb ^ (((sb >> 9) & 1) << 5); R = (st >> 1) * 16 + swz / 64; C = (st & 1) * 32 + (swz % 64) / 2; }
struct Unit { int pm, pn; };
struct Gemm { const bf16_t* A; const bf16_t* Bt; int M, N, K, lda, ldb; };
struct StaticOrder {
    int nM, nN, nwg, G, c;
    DI void init(int M_, int N_, int G_, int c_) { nM = M_ / BM; nN = N_ / BM; nwg = nM * nN; G = G_; c = c_; }
    DI bool next(int i, Unit& u) const {
        const long L = (long)i * G + c; if (L >= nwg) return false;
        int wgid = (int)L; { const int q = nwg / NXCD, r = nwg % NXCD, xcd = wgid % NXCD, off = wgid / NXCD; wgid = (xcd < r ? xcd * (q + 1) : r * (q + 1) + (xcd - r) * q) + off; }
        const int nig = WGM * nN, gid = wgid / nig, fm = gid * WGM, gsz = (nM - fm) < WGM ? (nM - fm) : WGM;
        u.pm = fm + ((wgid % nig) % gsz); u.pn = (wgid % nig) / gsz; return true;
    }
};
template <class Epi>
DI void gemm_phase(PG8_LAS unsigned char* lds, const Gemm g, const StaticOrder& S, const Epi& E) {
    const int tid = threadIdx.x, wid = __builtin_amdgcn_readfirstlane(tid >> 6), lane = tid & 63, wr = wid >> 2, wc = wid & 3, fr = lane & 15, fq = lane >> 4;
    const int K = g.K, nt = K / BK;
    unsigned voffA[2], voffB[2];
#pragma unroll
    for (int i = 0; i < 2; ++i) { int R, C; stage_rc(tid * 16 + i * 8192, R, C); voffA[i] = (unsigned)(R * g.lda + C) * 2u; voffB[i] = (unsigned)(R * g.ldb + C) * 2u; }
    const size_t kstep = (size_t)(BK * 2);
    const size_t hstepA = (size_t)HALF * g.lda * 2, hstepB = (size_t)HALF * g.ldb * 2;
    const size_t tstepA = 2 * hstepA, tstepB = 2 * hstepB;
    const unsigned ldsw = (unsigned)wid * 1024u;
    const int aoff = lds_byte(wr * 64 + fr, fq * 8), boff = lds_byte(wc * 32 + fr, fq * 8);
#define PG8_SA(b, h) (((b) * 2 + (h)) * HTB)
#define PG8_SB(b, h) ((4 + (b) * 2 + (h)) * HTB)
#define PG8_STAGE(bufoff, gbase, voff) do { _Pragma("unroll") for (int _i = 0; _i < 2; ++_i) \
        __builtin_amdgcn_global_load_lds((const unsigned*)((const char*)(gbase) + (voff)[_i]), (PG8_LAS unsigned*)(lds + (bufoff) + ldsw + _i * 8192), 16, 0, 0); } while (0)
#define PG8_LDA(dst, b, h) do { _Pragma("unroll") for (int m = 0; m < 4; ++m) _Pragma("unroll") for (int k = 0; k < 2; ++k) dst[m][k] = *(const PG8_LAS bf16x8*)(lds + PG8_SA(b, h) + aoff + m * 2048 + k * 1024); } while (0)
#define PG8_LDB(dst, b, h) do { _Pragma("unroll") for (int n = 0; n < 2; ++n) _Pragma("unroll") for (int k = 0; k < 2; ++k) dst[n][k] = *(const PG8_LAS bf16x8*)(lds + PG8_SB(b, h) + boff + n * 2048 + k * 1024); } while (0)
#define PG8_MMA(ai, bj, At, Bt) do { __builtin_amdgcn_s_setprio(1); _Pragma("unroll") for (int m = 0; m < 4; ++m) _Pragma("unroll") for (int n = 0; n < 2; ++n) _Pragma("unroll") for (int k = 0; k < 2; ++k) \
        acc[ai][bj][m][n] = __builtin_amdgcn_mfma_f32_16x16x32_bf16(Bt[n][k], At[m][k], acc[ai][bj][m][n], 0, 0, 0); __builtin_amdgcn_s_setprio(0); } while (0)
#define PG8_WAIT_V(n) asm volatile("s_waitcnt vmcnt(" #n ")" ::: "memory")
#define PG8_WAIT_L(n) asm volatile("s_waitcnt lgkmcnt(" #n ")" ::: "memory")
#define PG8_BAR __builtin_amdgcn_s_barrier()
#define PG8_SCHED __builtin_amdgcn_sched_barrier(0)
    Unit cur, nxt; int ui = 0;
    if (!S.next(0, cur)) return;
    f32x4 acc[2][2][4][2];
#pragma unroll
    for (int a = 0; a < 2; ++a)
#pragma unroll
        for (int b = 0; b < 2; ++b)
#pragma unroll
            for (int m = 0; m < 4; ++m)
#pragma unroll
                for (int n = 0; n < 2; ++n) acc[a][b][m][n] = (f32x4){0.f, 0.f, 0.f, 0.f};
    bf16x8 At[4][2], B0[2][2], B1[2][2];
    const char* cA = (const char*)g.A + (size_t)cur.pm * tstepA; const char* cB = (const char*)g.Bt + (size_t)cur.pn * tstepB;
    PG8_STAGE(PG8_SB(0, 0), cB, voffB); PG8_STAGE(PG8_SB(0, 1), cB + hstepB, voffB); PG8_STAGE(PG8_SA(0, 0), cA, voffA); PG8_STAGE(PG8_SA(0, 1), cA + hstepA, voffA);
    if (wr == 1) PG8_BAR;
    PG8_WAIT_V(2); PG8_BAR;
    PG8_STAGE(PG8_SB(1, 0), cB + kstep, voffB); PG8_STAGE(PG8_SA(1, 0), cA + kstep, voffA); PG8_STAGE(PG8_SB(1, 1), cB + hstepB + kstep, voffB);
    PG8_WAIT_V(6); PG8_BAR;
    for (;;) {
        const bool has_next = S.next(ui + 1, nxt);
        const char* nA = has_next ? (const char*)g.A + (size_t)nxt.pm * tstepA : cA; const char* nB = has_next ? (const char*)g.Bt + (size_t)nxt.pn * tstepB : cB;
#pragma unroll 1
        for (int t = 0; t < nt; t += 2) {
            const bool last = (t == nt - 2);
            const char* a1 = cA + (size_t)(t + 1) * kstep;
            const char* a2 = last ? nA : cA + (size_t)(t + 2) * kstep; const char* b2 = last ? nB : cB + (size_t)(t + 2) * kstep;
            const char* a3 = a2 + kstep; const char* b3 = b2 + kstep;
            PG8_LDB(B0, 0, 0); PG8_LDB(B1, 0, 1); PG8_SCHED; PG8_LDA(At, 0, 0); PG8_STAGE(PG8_SA(1, 1), a1 + hstepA, voffA);
            PG8_WAIT_V(8); PG8_WAIT_L(0); PG8_BAR; PG8_MMA(0, 0, At, B0); PG8_MMA(0, 1, At, B1); PG8_BAR; PG8_SCHED;
            PG8_LDA(At, 0, 1); PG8_STAGE(PG8_SB(0, 0), b2, voffB); PG8_STAGE(PG8_SB(0, 1), b2 + hstepB, voffB); PG8_STAGE(PG8_SA(0, 0), a2, voffA);
            PG8_WAIT_V(8); PG8_WAIT_L(0); PG8_BAR; PG8_MMA(1, 0, At, B0); PG8_MMA(1, 1, At, B1); PG8_BAR; PG8_SCHED;
            PG8_LDB(B0, 1, 0); PG8_LDB(B1, 1, 1); PG8_SCHED; PG8_LDA(At, 1, 0); PG8_STAGE(PG8_SA(0, 1), a2 + hstepA, voffA);
            PG8_WAIT_V(8); PG8_WAIT_L(0); PG8_BAR; PG8_MMA(0, 0, At, B0); PG8_MMA(0, 1, At, B1); PG8_BAR; PG8_SCHED;
            PG8_LDA(At, 1, 1); PG8_STAGE(PG8_SB(1, 0), b3, voffB); PG8_STAGE(PG8_SB(1, 1), b3 + hstepB, voffB); PG8_STAGE(PG8_SA(1, 0), a3, voffA);
            PG8_WAIT_V(8); PG8_WAIT_L(0); PG8_BAR; PG8_MMA(1, 0, At, B0); PG8_MMA(1, 1, At, B1); PG8_BAR; PG8_SCHED;
        }
        if (wr == 0) PG8_BAR;
        {
            const int row0 = cur.pm * BM + wr * 64 + fr, col0 = cur.pn * BM + wc * 32 + 4 * fq;
#pragma unroll
            for (int ai = 0; ai < 2; ++ai)
#pragma unroll
                for (int m = 0; m < 4; ++m)
#pragma unroll
                    for (int n = 0; n < 2; ++n) E(row0 + ai * HALF + m * 16, col0 + n * 16, acc[ai][0][m][n], acc[ai][1][m][n]);
        }
        if (!has_next) break;
#pragma unroll
        for (int a = 0; a < 2; ++a)
#pragma unroll
            for (int b = 0; b < 2; ++b)
#pragma unroll
                for (int m = 0; m < 4; ++m)
#pragma unroll
                    for (int n = 0; n < 2; ++n) acc[a][b][m][n] = (f32x4){0.f, 0.f, 0.f, 0.f};
        cur = nxt; cA = nA; cB = nB; ++ui;
        if (wr == 1) PG8_BAR;
    }
    PG8_WAIT_V(0);
    PG8_BAR;
#undef PG8_SA
#undef PG8_SB
#undef PG8_STAGE
#undef PG8_LDA
#undef PG8_LDB
#undef PG8_MMA
#undef PG8_WAIT_V
#undef PG8_WAIT_L
#undef PG8_BAR
#undef PG8_SCHED
}
}
template <class Epi>
DI void gemm_run(unsigned char* lds, const bf16_t* A, int lda, const bf16_t* Bt, int ldb, int Mm, int N, int K, const Epi& E) {
    pg8::Gemm g{A, Bt, Mm, N, K, lda, ldb}; pg8::StaticOrder S; S.init(Mm, N, (int)gridDim.x, (int)blockIdx.x);
    pg8::gemm_phase((PG8_LAS unsigned char*)lds, g, S, E);
}

struct EpiProjA { bf16_t* O; float* AB;
    DI void operator()(int r, int c, f32x4 a, f32x4 b) const { bf16_t* o = O + (size_t)r * NA + c; st4(o, a); st4(o + 128, b);
        if (c >= 3072 && c < 3088) *(f32x4*)(AB + (size_t)r * 16 + (c - 3072)) = a; } };
struct EpiStore { bf16_t* O; int ldo;
    DI void operator()(int r, int c, f32x4 a, f32x4 b) const { bf16_t* o = O + (size_t)r * ldo + c; st4(o, a); st4(o + 128, b); } };
struct EpiQ { bf16_t* O;
    DI void operator()(int r, int c, f32x4 a, f32x4 b) const { bf16_t* o = O + (size_t)r * 1536 + c; st4(o, a * C2); st4(o + 128, b * C2); } };
struct EpiKV { bf16_t* KN; bf16_t* V;
    DI void one(int r, int c, f32x4 v) const { if (c < 1024) st4(KN + (size_t)r * 1024 + c, v); else st4(V + (size_t)r * 1024 + c - 1024, v); }
    DI void operator()(int r, int c, f32x4 a, f32x4 b) const { one(r, c, a); one(r, c + 128, b); } };
struct EpiZG { bf16_t* Z; bf16_t* GD; bf16_t* GM;
    DI void one(int r, int c, f32x4 v) const { bf16_t* o = c < 1024 ? Z + c : (c < 2048 ? GD + (c - 1024) : GM + (c - 2048)); st4(o + (size_t)r * 1024, v); }
    DI void operator()(int r, int c, f32x4 a, f32x4 b) const { one(r, c, a); one(r, c + 128, b); } };
struct EpiYdn { bf16_t* GD;
    DI void one(int r, int c, f32x4 v) const { bf16_t* g = GD + (size_t)r * 1024 + c; const f32x4 gv = ld4(g);
        st4(g, (f32x4){sigm(gv[0]) * v[0], sigm(gv[1]) * v[1], sigm(gv[2]) * v[2], sigm(gv[3]) * v[3]}); }
    DI void operator()(int r, int c, f32x4 a, f32x4 b) const { one(r, c, a); one(r, c + 128, b); } };
struct EpiYmla { const bf16_t* GD; bf16_t* GM;
    DI void one(int r, int c, f32x4 v) const { bf16_t* g = GM + (size_t)r * 1024 + c; const f32x4 gv = ld4(g), tv = ld4(GD + (size_t)r * 1024 + c);
        st4(g, (f32x4){tv[0] + sigm(gv[0]) * v[0], tv[1] + sigm(gv[1]) * v[1], tv[2] + sigm(gv[2]) * v[2], tv[3] + sigm(gv[3]) * v[3]}); }
    DI void operator()(int r, int c, f32x4 a, f32x4 b) const { one(r, c, a); one(r, c + 128, b); } };
struct EpiWo { const float* x; float* T1;
    DI void one(int r, int c, f32x4 v) const { const size_t o = (size_t)r * D + c; *(f32x4*)(T1 + o) = *(const f32x4*)(x + o) * ALPHA + v; }
    DI void operator()(int r, int c, f32x4 a, f32x4 b) const { one(r, c, a); one(r, c + 128, b); } };
struct EpiFfnIn { bf16_t* ACT;
    DI void operator()(int r, int c, f32x4 a, f32x4 b) const { const int t = c >> 8, j = c & 255;
        st4(ACT + (size_t)r * FF + 128 * t + j, (f32x4){silu(a[0]) * b[0], silu(a[1]) * b[1], silu(a[2]) * b[2], silu(a[3]) * b[3]}); } };
struct EpiSg { bf16_t* SG;
    DI void one(int r, int c, f32x4 v) const { st4(SG + (size_t)r * D + c, (f32x4){sigm(v[0]), sigm(v[1]), sigm(v[2]), sigm(v[3])}); }
    DI void operator()(int r, int c, f32x4 a, f32x4 b) const { one(r, c, a); one(r, c + 128, b); } };
struct EpiFfnOut { float* H1; const bf16_t* SG; const bf16_t* PLE0;
    DI void one(int r, int c, f32x4 v) const { const size_t o = (size_t)r * D + c; *(f32x4*)(H1 + o) = *(const f32x4*)(H1 + o) * ALPHA + v + ld4(SG + o) * ld4(PLE0 + o); }
    DI void operator()(int r, int c, f32x4 a, f32x4 b) const { one(r, c, a); one(r, c + 128, b); } };

DI float sum16(float v) { v += __shfl_xor(v, 1); v += __shfl_xor(v, 2); v += __shfl_xor(v, 4); v += __shfl_xor(v, 8); return v; }
DI void unpack8(float* f, u32x4 u) { f[0] = bflo(u.x); f[1] = bfhi(u.x); f[2] = bflo(u.y); f[3] = bfhi(u.y); f[4] = bflo(u.z); f[5] = bfhi(u.z); f[6] = bflo(u.w); f[7] = bfhi(u.w); }
DI void p2_tokens(const Params& P, int gw, int ngw, int lane) {
    unsigned char* ws = P.ws;
    const bf16_t* PA = (const bf16_t*)(ws + O_PROJA); const float* AB = (const float*)(ws + O_AB);
    bf16_t* DQ = (bf16_t*)P.out; bf16_t* DK = DQ + (size_t)M * 1024; bf16_t* DV = (bf16_t*)(ws + O_DV);
    float* BETA = (float*)(ws + O_BETA); float* GG = (float*)(ws + O_GG);
    bf16_t* CQ = (bf16_t*)(ws + O_CQ); bf16_t* CKV = (bf16_t*)(ws + O_CKV); bf16_t* KR = (bf16_t*)(ws + O_KR);
    for (int it = gw; it < 6 * (M / 32); it += ngw) {
        const int seg = it % 6, m0 = (it / 6) * 32;
        const int c0 = seg * 512 + 8 * lane;
        float w[4][8];
#pragma unroll
        for (int i = 0; i < 4; ++i) { const f32x4 a = *(const f32x4*)(P.conv_w + i * 3072 + c0), b = *(const f32x4*)(P.conv_w + i * 3072 + c0 + 4);
            w[i][0] = a[0]; w[i][1] = a[1]; w[i][2] = a[2]; w[i][3] = a[3]; w[i][4] = b[0]; w[i][5] = b[1]; w[i][6] = b[2]; w[i][7] = b[3]; }
        float xw[3][8];
        const bool first = (m0 % S) == 0;
#pragma unroll
        for (int i = 0; i < 3; ++i) { u32x4 u = (u32x4){0u, 0u, 0u, 0u}; if (!first) u = *(const u32x4*)(PA + (size_t)(m0 - 3 + i) * NA + c0); unpack8(xw[i], u); }
        bf16_t* dst = (seg < 2 ? DQ : (seg < 4 ? DK : DV)) + (seg & 1) * 512 + 8 * lane;
        const float qs = seg < 2 ? 0.08838834764831845f : 1.f;
        for (int t = 0; t < 32; t += 4) {
            u32x4 un[4];
#pragma unroll
            for (int q = 0; q < 4; ++q) un[q] = *(const u32x4*)(PA + (size_t)(m0 + t + q) * NA + c0);
#pragma unroll
            for (int q = 0; q < 4; ++q) {
                float xc[8]; unpack8(xc, un[q]);
                float a[8]; float ss = 0.f;
#pragma unroll
                for (int j = 0; j < 8; ++j) { a[j] = silu(w[0][j] * xw[0][j] + w[1][j] * xw[1][j] + w[2][j] * xw[2][j] + w[3][j] * xc[j]); ss += a[j] * a[j]; }
                if (seg < 4) { const float r = rsqrtf(sum16(ss) + 1e-6f) * qs;
#pragma unroll
                    for (int j = 0; j < 8; ++j) a[j] *= r; }
                u32x4 o; o.x = pk2(a[0], a[1]); o.y = pk2(a[2], a[3]); o.z = pk2(a[4], a[5]); o.w = pk2(a[6], a[7]);
                *(u32x4*)(dst + (size_t)(m0 + t + q) * 1024) = o;
#pragma unroll
                for (int j = 0; j < 8; ++j) { xw[0][j] = xw[1][j]; xw[1][j] = xw[2][j]; xw[2][j] = xc[j]; }
            }
        }
    }
    const int sub = lane >> 4, l16 = lane & 15;
    for (int it = gw; it < M / 4; it += ngw) {
        const int m = it * 4 + sub;
        const bf16_t* row = PA + (size_t)m * NA;
        if (l16 < 8) { const float br = AB[(size_t)m * 16 + l16], ar = AB[(size_t)m * 16 + 8 + l16];
            BETA[(size_t)m * 8 + l16] = sigm(br);
            const float xx = ar + P.dt_bias[l16]; const float sp = fmaxf(xx, 0.f) + log1pf(__expf(-fabsf(xx)));
            GG[(size_t)m * 8 + l16] = -__expf(P.a_log[l16]) * sp; }
        {
            float v[3][8]; float ss = 0.f;
#pragma unroll
            for (int j = 0; j < 3; ++j) { unpack8(v[j], *(const u32x4*)(row + 3088 + 8 * (l16 + 16 * j)));
#pragma unroll
                for (int e = 0; e < 8; ++e) ss += v[j][e] * v[j][e]; }
            const float r = rsqrtf(sum16(ss) * (1.f / 384.f) + 1e-6f);
#pragma unroll
            for (int j = 0; j < 3; ++j) { const int idx = 8 * (l16 + 16 * j); const f32x4 wa = *(const f32x4*)(P.q_norm_w + idx), wb = *(const f32x4*)(P.q_norm_w + idx + 4);
                u32x4 o; o.x = pk2(v[j][0] * r * wa[0], v[j][1] * r * wa[1]); o.y = pk2(v[j][2] * r * wa[2], v[j][3] * r * wa[3]); o.z = pk2(v[j][4] * r * wb[0], v[j][5] * r * wb[1]); o.w = pk2(v[j][6] * r * wb[2], v[j][7] * r * wb[3]);
                *(u32x4*)(CQ + (size_t)m * 384 + idx) = o; }
        }
        {
            float v[2][8]; float ss = 0.f;
#pragma unroll
            for (int j = 0; j < 2; ++j) { unpack8(v[j], *(const u32x4*)(row + 3472 + 8 * (l16 + 16 * j)));
#pragma unroll
                for (int e = 0; e < 8; ++e) ss += v[j][e] * v[j][e]; }
            const float r = rsqrtf(sum16(ss) * (1.f / 256.f) + 1e-6f);
#pragma unroll
            for (int j = 0; j < 2; ++j) { const int idx = 8 * (l16 + 16 * j); const f32x4 wa = *(const f32x4*)(P.kv_norm_w + idx), wb = *(const f32x4*)(P.kv_norm_w + idx + 4);
                u32x4 o; o.x = pk2(v[j][0] * r * wa[0], v[j][1] * r * wa[1]); o.y = pk2(v[j][2] * r * wa[2], v[j][3] * r * wa[3]); o.z = pk2(v[j][4] * r * wb[0], v[j][5] * r * wb[1]); o.w = pk2(v[j][6] * r * wb[2], v[j][7] * r * wb[3]);
                *(u32x4*)(CKV + (size_t)m * 256 + idx) = o; }
        }
        {
            const unsigned ua = *(const unsigned*)(row + 3728 + 2 * l16), ub = *(const unsigned*)(row + 3728 + 32 + 2 * l16);
            const int ps = P.pos[m]; float c0_, s0_, c1_, s1_; rope_cs(ps, 2 * l16, c0_, s0_); rope_cs(ps, 2 * l16 + 1, c1_, s1_);
            const float a1 = bflo(ua), a2 = bflo(ub), b1 = bfhi(ua), b2 = bfhi(ub);
            u32x2 o; o.x = pk2(a1 * c0_ - a2 * s0_, a2 * c0_ + a1 * s0_); o.y = pk2(b1 * c1_ - b2 * s1_, b2 * c1_ + b1 * s1_);
            *(u32x2*)(KR + (size_t)m * 64 + 4 * l16) = o;
        }
    }
}

typedef float f32x16 __attribute__((ext_vector_type(16)));
typedef short s16x4 __attribute__((ext_vector_type(4)));
#define LAS __attribute__((address_space(3)))
typedef LAS unsigned char* lptr;
DI s16x4 vtr(lptr p) { return __builtin_bit_cast(s16x4, __builtin_amdgcn_ds_read_tr16_b64_v4i16((LAS s16x4*)p)); }
#define MFMA32(a, b, c) __builtin_amdgcn_mfma_f32_32x32x16_bf16((a), (b), (c), 0, 0, 0)
DI bf16x8 pack8(const f32x16& x, int o) { u32x4 p; p.x = pk2(x[o], x[o + 1]); p.y = pk2(x[o + 2], x[o + 3]); p.z = pk2(x[o + 4], x[o + 5]); p.w = pk2(x[o + 6], x[o + 7]); return __builtin_bit_cast(bf16x8, p); }
DI void attn_unit(const Params& P, unsigned char* lds_, int bh, int qb) {
    lptr lds = (lptr)lds_;
    constexpr int KP = 400, VP = 272, KBUF = 64 * KP, VBUF = 64 * VP;
    unsigned char* ws = P.ws;
    bf16_t* Qg = (bf16_t*)(ws + O_Q); const bf16_t* KN = (const bf16_t*)(ws + O_KN); const bf16_t* V = (const bf16_t*)(ws + O_V); const bf16_t* KR = (const bf16_t*)(ws + O_KR);
    const int tid = threadIdx.x, lane = tid & 63, w = __builtin_amdgcn_readfirstlane(tid >> 6), r32 = lane & 31, hi = lane >> 5;
    const int b = bh >> 3, h = bh & 7;
    const size_t rowb = (size_t)b * S;
    {
        {
            const int q0 = qb * 256, NT = (q0 + 256) / 64;
            const int qrow = q0 + 32 * w + r32;
            bf16x8 qf[12];
            { const bf16_t* qp = Qg + (rowb + qrow) * 1536 + h * 192 + 8 * hi;
#pragma unroll
              for (int ks = 0; ks < 12; ++ks) qf[ks] = *(const bf16x8*)(qp + 16 * ks);
              const int ps = P.pos[rowb + qrow];
#pragma unroll
              for (int ks = 8; ks < 12; ++ks) { u32x4 u = __builtin_bit_cast(u32x4, qf[ks]);
#pragma unroll
                  for (int pj = 0; pj < 4; ++pj) { float c, s; rope_cs(ps, 8 * (ks - 8) + 4 * hi + pj, c, s); const unsigned w = u[pj]; const float t1 = bflo(w), t2 = bfhi(w); u[pj] = pk2(t1 * c - t2 * s, t2 * c + t1 * s); }
                  qf[ks] = __builtin_bit_cast(bf16x8, u); } }
            const bf16_t* kn_src = KN + (rowb + (tid >> 4)) * 1024 + h * 128 + (tid & 15) * 8;
            const bf16_t* kr_src = KR + (rowb + (tid >> 3)) * 64 + (tid & 7) * 8;
            const bf16_t* v_src = V + (rowb + (tid >> 4)) * 1024 + h * 128 + (tid & 15) * 8;
            const int kdst = (tid >> 4) * KP + (tid & 15) * 16, krdst = (tid >> 3) * KP + 256 + (tid & 7) * 16, vdst = (tid >> 4) * VP + (tid & 15) * 16;
            u32x4 st0, st1, st2, st3, st4_;
#define LOADT(kt) do { const size_t o_ = (size_t)(kt) * 64; st0 = *(const u32x4*)(kn_src + o_ * 1024); st1 = *(const u32x4*)(kn_src + (o_ + 32) * 1024); st2 = *(const u32x4*)(kr_src + o_ * 64); \
                       st3 = *(const u32x4*)(v_src + o_ * 1024); st4_ = *(const u32x4*)(v_src + (o_ + 32) * 1024); } while (0)
#define STORET(buf) do { lptr kb_ = lds + (buf) * KBUF; lptr vb_ = lds + 2 * KBUF + (buf) * VBUF; *(LAS u32x4*)(kb_ + kdst) = st0; *(LAS u32x4*)(kb_ + kdst + 32 * KP) = st1; *(LAS u32x4*)(kb_ + krdst) = st2; \
                         *(LAS u32x4*)(vb_ + vdst) = st3; *(LAS u32x4*)(vb_ + vdst + 32 * VP) = st4_; } while (0)
            __syncthreads();
            LOADT(0); STORET(0);
            __syncthreads();
            f32x16 o[4];
#pragma unroll
            for (int d = 0; d < 4; ++d)
#pragma unroll
                for (int i = 0; i < 16; ++i) o[d][i] = 0.f;
            float m_run = -1e30f, l_run = 0.f;
            for (int kt = 0; kt < NT; ++kt) {
                const int buf = kt & 1;
                if (kt + 1 < NT) LOADT(kt + 1);
                if (64 * kt <= q0 + 32 * w + 31) {
                    lptr kb = lds + buf * KBUF + r32 * KP + hi * 16;
                    f32x16 s0, s1;
#pragma unroll
                    for (int i = 0; i < 16; ++i) { s0[i] = 0.f; s1[i] = 0.f; }
#pragma unroll
                    for (int ks = 0; ks < 12; ++ks) { const bf16x8 a0 = *(const LAS bf16x8*)(kb + ks * 32), a1 = *(const LAS bf16x8*)(kb + 32 * KP + ks * 32);
                        s0 = MFMA32(a0, qf[ks], s0); s1 = MFMA32(a1, qf[ks], s1); }
                    if (64 * kt + 63 > q0 + 32 * w) {
                        const int kv0 = 64 * kt + 4 * hi;
#pragma unroll
                        for (int i = 0; i < 16; ++i) { const int kv = kv0 + (i & 3) + 8 * (i >> 2); if (kv > qrow) s0[i] = -1e30f; if (kv + 32 > qrow) s1[i] = -1e30f; }
                    }
                    float mx = fmaxf(s0[0], s1[0]);
#pragma unroll
                    for (int i = 1; i < 16; ++i) mx = fmaxf(mx, fmaxf(s0[i], s1[i]));
                    mx = fmaxf(mx, __shfl_xor(mx, 32));
                    const float m_new = fmaxf(m_run, mx);
                    if (__builtin_amdgcn_ballot_w64(m_new > m_run) != 0ull) {
                        const float al = __builtin_amdgcn_exp2f(m_run - m_new); l_run *= al;
#pragma unroll
                        for (int d = 0; d < 4; ++d) o[d] = o[d] * al;
                    }
                    m_run = m_new;
                    float ps = 0.f;
#pragma unroll
                    for (int i = 0; i < 16; ++i) { s0[i] = __builtin_amdgcn_exp2f(s0[i] - m_new); s1[i] = __builtin_amdgcn_exp2f(s1[i] - m_new); ps += s0[i] + s1[i]; }
                    l_run += ps;
                    bf16x8 pf[4]; pf[0] = pack8(s0, 0); pf[1] = pack8(s0, 8); pf[2] = pack8(s1, 0); pf[3] = pack8(s1, 8);
                    __builtin_amdgcn_sched_barrier(0);
                    lptr vb = lds + 2 * KBUF + buf * VBUF + (4 * hi + ((lane & 15) >> 2)) * VP + (((lane >> 4) & 1) * 16 + (lane & 3) * 4) * 2;
#pragma unroll
                    for (int s = 0; s < 4; ++s)
#pragma unroll
                        for (int d = 0; d < 4; ++d) { const s16x4 lo = vtr(vb + s * 16 * VP + d * 64), hh = vtr(vb + (s * 16 + 8) * VP + d * 64);
                            const bf16x8 a = __builtin_shufflevector(lo, hh, 0, 1, 2, 3, 4, 5, 6, 7); o[d] = MFMA32(a, pf[s], o[d]); }
                }
                if (kt + 1 < NT) STORET(buf ^ 1);
                __syncthreads();
            }
#undef LOADT
#undef STORET
            l_run += __shfl_xor(l_run, 32);
            const float il = 1.f / l_run;
            bf16_t* op = Qg + (rowb + qrow) * 1536 + h * 192 + 4 * hi;
#pragma unroll
            for (int d = 0; d < 4; ++d)
#pragma unroll
                for (int g = 0; g < 4; ++g) st4(op + 32 * d + 8 * g, (f32x4){o[d][4 * g], o[d][4 * g + 1], o[d][4 * g + 2], o[d][4 * g + 3]} * il);
        }
    }
}

DI void attn_queue(const Params& P, unsigned char* lds_, unsigned* qcnt) {
    LAS int* slot = (LAS int*)((lptr)lds_ + 147392);
    const int myx = blockIdx.x & 7;
    for (int qq = 0; qq < 8; ++qq) {
        const int x = (myx + qq) & 7;
        for (;;) {
            __syncthreads();
            if (threadIdx.x == 0) *slot = (int)__hip_atomic_fetch_add(qcnt + 64 * x, 1u, __ATOMIC_RELAXED, __HIP_MEMORY_SCOPE_AGENT);
            __syncthreads();
            const int k = *slot;
            if (k >= 64) break;
            attn_unit(P, lds_, 4 * x + (k & 3), 15 - (k >> 2));
        }
    }
}

#define LFENCE() asm volatile("s_waitcnt lgkmcnt(0)" ::: "memory")
DI int crow(int r, int hi) { return (r & 3) + 8 * (r >> 2) + 4 * hi; }
DI unsigned char* rawp(unsigned char* basep, size_t m0, int h, int o) { return basep + (m0 + (size_t)(o >> 8)) * 2048 + h * 256 + (o & 255); }
DI void store_raw(unsigned char* p, const f32x16& x) { *(u32x4*)p = __builtin_bit_cast(u32x4, pack8(x, 0)); *(u32x4*)(p + 16) = __builtin_bit_cast(u32x4, pack8(x, 8)); }
DI void delta_A(const Params& P, unsigned char* lds_, int gw, int ngw, int lane, int wid) {
    unsigned char* ws = P.ws;
    lptr base = (lptr)lds_ + wid * 18432;
    LAS float* Lm = (LAS float*)base;
    LAS float* gc = (LAS float*)(base + 17408); LAS float* bu = gc + 64; LAS float* bw = bu + 64; LAS float* tl = bw + 64;
    bf16_t* DQ = (bf16_t*)P.out; const bf16_t* DK = DQ + (size_t)M * 1024; const bf16_t* DV = (const bf16_t*)(ws + O_DV);
    const float* BETA = (const float*)(ws + O_BETA); const float* GG = (const float*)(ws + O_GG); float* EGL = (float*)(ws + O_EGL);
    for (int ch = gw; ch < 2048; ch += ngw) {
        asm volatile("" : "+v"(lane));
        const int r32 = lane & 31, hi = lane >> 5;
        const int h = ch & 7, bn = ch >> 3, b = bn >> 6, n = bn & 63; const size_t m0 = (size_t)b * S + 64 * n;
        LFENCE();
        {
            float g = GG[(m0 + lane) * 8 + h]; const float be = BETA[(m0 + lane) * 8 + h];
#pragma unroll
            for (int o = 1; o < 64; o <<= 1) { const float t = __shfl_up(g, o); if (lane >= o) g += t; }
            const float gl = __shfl(g, 63);
            gc[lane] = g; bu[lane] = be; bw[lane] = -be * __expf(g); tl[lane] = __expf(gl - g);
            if (lane == 0) EGL[ch] = __expf(gl);
        }
        LFENCE();
        {
#pragma unroll
            for (int t = 0; t < 3; ++t) { const int ib = t == 0 ? 0 : 1, jb = t == 2 ? 1 : 0;
                asm volatile("" ::: "memory");
                f32x16 x;
#pragma unroll
                for (int i = 0; i < 16; ++i) x[i] = 0.f;
#pragma unroll
                for (int ks = 0; ks < 8; ++ks) { const bf16x8 ka = *(const bf16x8*)(DK + (m0 + 32 * ib + r32) * 1024 + h * 128 + 16 * ks + 8 * hi), kb = *(const bf16x8*)(DK + (m0 + 32 * jb + r32) * 1024 + h * 128 + 16 * ks + 8 * hi);
                    x = MFMA32(ka, kb, x); }
                const int j = 32 * jb + r32; const float gcj = gc[j];
#pragma unroll
                for (int r = 0; r < 16; ++r) { const int i = 32 * ib + crow(r, hi); Lm[i * 68 + j] = (j < i) ? bu[i] * x[r] * __expf(gc[i] - gcj) : 0.f; }
            }
#pragma unroll
            for (int r = 0; r < 16; ++r) Lm[crow(r, hi) * 68 + 32 + r32] = 0.f;
#pragma unroll
            for (int t = 0; t < 3; ++t) { const int jb = t == 2 ? 1 : 0, ib = t == 0 ? 0 : 1;
                asm volatile("" ::: "memory");
                f32x16 x;
#pragma unroll
                for (int q = 0; q < 16; ++q) x[q] = 0.f;
#pragma unroll
                for (int ks = 0; ks < 8; ++ks) { const bf16x8 ka = *(const bf16x8*)(DK + (m0 + 32 * jb + r32) * 1024 + h * 128 + 16 * ks + 8 * hi), qb = *(const bf16x8*)(DQ + (m0 + 32 * ib + r32) * 1024 + h * 128 + 16 * ks + 8 * hi);
                    x = MFMA32(ka, qb, x); }
                const int i = 32 * ib + r32; const float gci = gc[i];
#pragma unroll
                for (int r = 0; r < 16; ++r) { const int j = 32 * jb + crow(r, hi); x[r] = (j <= i) ? x[r] * __expf(gci - gc[j]) : 0.f; }
                store_raw(ws + O_INTRA + (size_t)ch * 6144 + t * 2048 + lane * 32, x);
            }
        }
        LFENCE();
        {
            float t[64];
            t[0] = (lane == 0) ? 1.f : 0.f;
#pragma unroll
            for (int i = 1; i < 64; ++i) {
                float a0 = 0.f, a1 = 0.f, a2 = 0.f, a3 = 0.f;
#pragma unroll
                for (int j = 0; j < i; j += 4) { const f32x4 l4 = *(const LAS f32x4*)(Lm + i * 68 + j);
                    a0 += l4[0] * t[j]; if (j + 1 < i) a1 += l4[1] * t[j + 1]; if (j + 2 < i) a2 += l4[2] * t[j + 2]; if (j + 3 < i) a3 += l4[3] * t[j + 3]; }
                t[i] = ((lane == i) ? 1.f : 0.f) - ((a0 + a1) + (a2 + a3));
            }
            LFENCE();
#pragma unroll
            for (int i = 0; i < 64; ++i) Lm[i * 68 + lane] = t[i];
        }
        LFENCE();
        bf16x8 Tu[6], Tw[6];
#pragma unroll
        for (int q = 0; q < 6; ++q) { const int ib = q < 2 ? 0 : 1, s = q < 2 ? q : q - 2; const int i = 32 * ib + r32;
            const LAS float* tp = Lm + i * 68 + 16 * s + 8 * hi; const f32x4 t0 = *(const LAS f32x4*)tp, t1 = *(const LAS f32x4*)(tp + 4);
            const f32x4 u0 = *(const LAS f32x4*)(bu + 16 * s + 8 * hi), u1 = *(const LAS f32x4*)(bu + 16 * s + 8 * hi + 4);
            const f32x4 w0 = *(const LAS f32x4*)(bw + 16 * s + 8 * hi), w1 = *(const LAS f32x4*)(bw + 16 * s + 8 * hi + 4);
            const f32x4 a0 = t0 * u0, a1 = t1 * u1, c0 = t0 * w0, c1 = t1 * w1;
            u32x4 pu, pw; pu.x = pk2(a0[0], a0[1]); pu.y = pk2(a0[2], a0[3]); pu.z = pk2(a1[0], a1[1]); pu.w = pk2(a1[2], a1[3]);
            pw.x = pk2(c0[0], c0[1]); pw.y = pk2(c0[2], c0[3]); pw.z = pk2(c1[0], c1[1]); pw.w = pk2(c1[2], c1[3]);
            Tu[q] = __builtin_bit_cast(bf16x8, pu); Tw[q] = __builtin_bit_cast(bf16x8, pw); }
        const float tli = tl[r32], tli1 = tl[32 + r32], eg0 = __expf(gc[r32]), eg1 = __expf(gc[32 + r32]);
        LFENCE();
#pragma unroll 4
        for (int it = 0; it < 16; ++it) { const int idx = it * 64 + lane, row = idx >> 4, c16 = idx & 15;
            *(LAS u32x4*)(base + row * 272 + c16 * 16) = *(const u32x4*)(DV + (m0 + row) * 1024 + h * 128 + c16 * 8); }
        LFENCE();
        lptr vb = base + (8 * hi + ((lane & 15) >> 2)) * 272 + (((lane >> 4) & 1) * 16 + (lane & 3) * 4) * 2;
#pragma unroll 1
        for (int eb = 0; eb < 4; ++eb) {
            bf16x8 vf[4];
#pragma unroll
            for (int s = 0; s < 4; ++s) { const s16x4 lo = vtr(vb + 16 * s * 272 + eb * 64), hh = vtr(vb + (16 * s + 4) * 272 + eb * 64); vf[s] = __builtin_shufflevector(lo, hh, 0, 1, 2, 3, 4, 5, 6, 7); }
#pragma unroll
            for (int ib = 0; ib < 2; ++ib) { f32x16 x;
#pragma unroll
                for (int i = 0; i < 16; ++i) x[i] = 0.f;
#pragma unroll
                for (int s = 0; s < 4; ++s) if (ib == 1 || s < 2) x = MFMA32(Tu[ib == 0 ? s : 2 + s], vf[s], x);
                store_raw(rawp(ws + O_DV, m0, h, (eb * 2 + ib) * 2048 + lane * 32), x); }
        }
        LFENCE();
#pragma unroll 4
        for (int it = 0; it < 16; ++it) { const int idx = it * 64 + lane, row = idx >> 4, c16 = idx & 15;
            *(LAS u32x4*)(base + row * 272 + c16 * 16) = *(const u32x4*)(DK + (m0 + row) * 1024 + h * 128 + c16 * 8); }
        LFENCE();
#pragma unroll 1
        for (int dkb = 0; dkb < 4; ++dkb) {
            bf16x8 kf[4];
#pragma unroll
            for (int s = 0; s < 4; ++s) { const s16x4 lo = vtr(vb + 16 * s * 272 + dkb * 64), hh = vtr(vb + (16 * s + 4) * 272 + dkb * 64); kf[s] = __builtin_shufflevector(lo, hh, 0, 1, 2, 3, 4, 5, 6, 7); }
#pragma unroll
            for (int ib = 0; ib < 2; ++ib) { f32x16 x;
#pragma unroll
                for (int i = 0; i < 16; ++i) x[i] = 0.f;
#pragma unroll
                for (int s = 0; s < 4; ++s) if (ib == 1 || s < 2) x = MFMA32(kf[s], Tw[ib == 0 ? s : 2 + s], x);
                store_raw(ws + O_WT + (size_t)ch * 16384 + (dkb * 2 + ib) * 2048 + lane * 32, x); }
#pragma unroll
            for (int ib = 0; ib < 2; ++ib) { f32x16 x;
#pragma unroll
                for (int i = 0; i < 16; ++i) x[i] = 0.f;
                const unsigned tb = f2bf(ib ? tli1 : tli);
#pragma unroll
                for (int t = 0; t < 2; ++t) { const int rel = r32 - 16 * t - 8 * hi;
                    u32x4 d; d.x = (rel == 0 ? tb : 0u) | (rel == 1 ? tb << 16 : 0u); d.y = (rel == 2 ? tb : 0u) | (rel == 3 ? tb << 16 : 0u);
                    d.z = (rel == 4 ? tb : 0u) | (rel == 5 ? tb << 16 : 0u); d.w = (rel == 6 ? tb : 0u) | (rel == 7 ? tb << 16 : 0u);
                    x = MFMA32(__builtin_bit_cast(bf16x8, d), kf[2 * ib + t], x); }
                store_raw(rawp((unsigned char*)DQ + (size_t)M * 2048, m0, h, (ib * 4 + dkb) * 2048 + lane * 32), x); }
        }
        LFENCE();
#pragma unroll 4
        for (int it = 0; it < 16; ++it) { const int idx = it * 64 + lane, row = idx >> 4, c16 = idx & 15;
            *(LAS u32x4*)(base + row * 272 + c16 * 16) = *(const u32x4*)(DQ + (m0 + row) * 1024 + h * 128 + c16 * 8); }
        asm volatile("s_waitcnt vmcnt(0) lgkmcnt(0)" ::: "memory");
#pragma unroll
        for (int blk = 0; blk < 8; ++blk) { const int dkb = blk >> 1, ib = blk & 1; const float e = ib ? eg1 : eg0;
            lptr qp = base + (32 * ib + r32) * 272 + (32 * dkb + 4 * hi) * 2;
            u32x2 q0 = *(const LAS u32x2*)qp, q1 = *(const LAS u32x2*)(qp + 16), q2 = *(const LAS u32x2*)(qp + 32), q3 = *(const LAS u32x2*)(qp + 48);
            u32x4 lo, hh;
            lo.x = pk2(bflo(q0.x) * e, bfhi(q0.x) * e); lo.y = pk2(bflo(q0.y) * e, bfhi(q0.y) * e); lo.z = pk2(bflo(q1.x) * e, bfhi(q1.x) * e); lo.w = pk2(bflo(q1.y) * e, bfhi(q1.y) * e);
            hh.x = pk2(bflo(q2.x) * e, bfhi(q2.x) * e); hh.y = pk2(bflo(q2.y) * e, bfhi(q2.y) * e); hh.z = pk2(bflo(q3.x) * e, bfhi(q3.x) * e); hh.w = pk2(bflo(q3.y) * e, bfhi(q3.y) * e);
            const int o = blk * 2048 + lane * 32;
            unsigned char* dst = (unsigned char*)DQ + (m0 + (o >> 8)) * 2048 + h * 256 + (o & 255);
            *(u32x4*)dst = lo; *(u32x4*)(dst + 16) = hh; }
    }
}
DI void unpack16(f32x16& x, const unsigned char* p) { const u32x4 a = *(const u32x4*)p, b = *(const u32x4*)(p + 16);
    x[0] = bflo(a.x); x[1] = bfhi(a.x); x[2] = bflo(a.y); x[3] = bfhi(a.y); x[4] = bflo(a.z); x[5] = bfhi(a.z); x[6] = bflo(a.w); x[7] = bfhi(a.w);
    x[8] = bflo(b.x); x[9] = bfhi(b.x); x[10] = bflo(b.y); x[11] = bfhi(b.y); x[12] = bflo(b.z); x[13] = bfhi(b.z); x[14] = bflo(b.w); x[15] = bfhi(b.w); }
#define RAWBAR() do { asm volatile("s_waitcnt lgkmcnt(0)" ::: "memory"); __builtin_amdgcn_s_barrier(); asm volatile("" ::: "memory"); } while (0)
DI void delta_B2(const Params& P, unsigned char* lds_, int bh) {
    lptr lds = (lptr)lds_;
    constexpr int BUF = 55296;
    unsigned char* ws = P.ws;
    const int tid = threadIdx.x, lane = tid & 63, wid = __builtin_amdgcn_readfirstlane(tid >> 6);
    const int b = bh >> 3, h = bh & 7;
    unsigned char* dq = (unsigned char*)P.out; unsigned char* dk = dq + (size_t)M * 2048; unsigned char* dv = ws + O_DV;
    __syncthreads();
    if (wid >= 4) {
        const int tl = tid - 256;
        u32x4 ra[14], rb[14];
#define DB_LD(n, r) do { const int ch_ = (b * 64 + (n)) * 8 + h; const size_t m0_ = (size_t)b * S + 64 * (n); \
        _Pragma("unroll") for (int j = 0; j < 14; ++j) { const int idx = tl + 256 * j; if (j < 13 || tl < 128) { const unsigned char* s_; \
            if (j < 4) s_ = ws + O_WT + (size_t)ch_ * 16384 + idx * 16; \
            else if (j < 8) s_ = rawp(dq, m0_, h, (idx - 1024) * 16); \
            else if (j < 12) s_ = rawp(dk, m0_, h, (idx - 2048) * 16); \
            else s_ = ws + O_INTRA + (size_t)ch_ * 6144 + (idx - 3072) * 16; \
            r[j] = *(const u32x4*)s_; } } } while (0)
#define DB_ST(bufi, r) do { _Pragma("unroll") for (int j = 0; j < 14; ++j) { const int idx = tl + 256 * j; if (j < 13 || tl < 128) *(LAS u32x4*)(lds + (bufi) * BUF + idx * 16) = r[j]; } } while (0)
        DB_LD(0, ra); DB_LD(1, rb); DB_ST(0, ra); DB_LD(2, ra);
        __syncthreads();
        for (int n = 0; n < 64; n += 2) {
            DB_ST(1, rb); if (n + 3 < 64) DB_LD(n + 3, rb);
            RAWBAR();
            if (n + 2 < 64) { DB_ST(0, ra); if (n + 4 < 64) DB_LD(n + 4, ra); }
            RAWBAR();
        }
#undef DB_LD
#undef DB_ST
    } else {
        const int eb = wid;
        const float* EGL = (const float*)(ws + O_EGL);
        f32x16 St[4];
#pragma unroll
        for (int d = 0; d < 4; ++d)
#pragma unroll
            for (int i = 0; i < 16; ++i) St[d][i] = 0.f;
        u32x4 up[4];
        { unsigned char* u0 = rawp(dv, (size_t)b * S, h, (eb * 2) * 2048 + lane * 32), *u1 = rawp(dv, (size_t)b * S, h, (eb * 2 + 1) * 2048 + lane * 32);
          up[0] = *(const u32x4*)u0; up[1] = *(const u32x4*)(u0 + 16); up[2] = *(const u32x4*)u1; up[3] = *(const u32x4*)(u1 + 16); }
        __syncthreads();
        for (int n = 0; n < 64; ++n) {
            const int ch = (b * 64 + n) * 8 + h; const size_t m0 = (size_t)b * S + 64 * n;
            lptr bf = lds + (n & 1) * BUF + lane * 32;
            const float eg = EGL[ch];
            f32x16 vn[2], ob[2];
#pragma unroll
            for (int ib = 0; ib < 2; ++ib) { const u32x4 a = up[2 * ib], c = up[2 * ib + 1];
                vn[ib][0] = bflo(a.x); vn[ib][1] = bfhi(a.x); vn[ib][2] = bflo(a.y); vn[ib][3] = bfhi(a.y); vn[ib][4] = bflo(a.z); vn[ib][5] = bfhi(a.z); vn[ib][6] = bflo(a.w); vn[ib][7] = bfhi(a.w);
                vn[ib][8] = bflo(c.x); vn[ib][9] = bfhi(c.x); vn[ib][10] = bflo(c.y); vn[ib][11] = bfhi(c.y); vn[ib][12] = bflo(c.z); vn[ib][13] = bfhi(c.z); vn[ib][14] = bflo(c.w); vn[ib][15] = bfhi(c.w); }
            unsigned char* o0 = rawp(dv, m0, h, (eb * 2) * 2048 + lane * 32); unsigned char* o1 = rawp(dv, m0, h, (eb * 2 + 1) * 2048 + lane * 32);
            if (n + 1 < 64) { const unsigned char* u0 = rawp(dv, m0 + 64, h, (eb * 2) * 2048 + lane * 32); const unsigned char* u1 = rawp(dv, m0 + 64, h, (eb * 2 + 1) * 2048 + lane * 32);
                up[0] = *(const u32x4*)u0; up[1] = *(const u32x4*)(u0 + 16); up[2] = *(const u32x4*)u1; up[3] = *(const u32x4*)(u1 + 16); }
            bf16x8 Spk[8];
#pragma unroll
            for (int s = 0; s < 8; ++s) Spk[s] = pack8(St[s >> 1], 8 * (s & 1));
#pragma unroll
            for (int i = 0; i < 16; ++i) { ob[0][i] = 0.f; ob[1][i] = 0.f; }
#pragma unroll
            for (int s = 0; s < 8; ++s)
#pragma unroll
                for (int ib = 0; ib < 2; ++ib) { const int o = ((s >> 1) * 2 + ib) * 2048 + 16 * (s & 1);
                    vn[ib] = MFMA32(*(const LAS bf16x8*)(bf + o), Spk[s], vn[ib]);
                    ob[ib] = MFMA32(*(const LAS bf16x8*)(bf + 16384 + o), Spk[s], ob[ib]); }
            bf16x8 vpk[2][2];
#pragma unroll
            for (int ib = 0; ib < 2; ++ib) { vpk[ib][0] = pack8(vn[ib], 0); vpk[ib][1] = pack8(vn[ib], 8); }
#pragma unroll
            for (int t = 0; t < 2; ++t) {
                ob[0] = MFMA32(*(const LAS bf16x8*)(bf + 49152 + 0 * 2048 + 16 * t), vpk[0][t], ob[0]);
                ob[1] = MFMA32(*(const LAS bf16x8*)(bf + 49152 + 1 * 2048 + 16 * t), vpk[0][t], ob[1]);
                ob[1] = MFMA32(*(const LAS bf16x8*)(bf + 49152 + 2 * 2048 + 16 * t), vpk[1][t], ob[1]);
            }
            store_raw(o0, ob[0]); store_raw(o1, ob[1]);
#pragma unroll
            for (int dkb = 0; dkb < 4; ++dkb) { St[dkb] = St[dkb] * eg;
#pragma unroll
                for (int s = 0; s < 4; ++s) St[dkb] = MFMA32(*(const LAS bf16x8*)(bf + 32768 + ((s >> 1) * 4 + dkb) * 2048 + 16 * (s & 1)), vpk[s >> 1][s & 1], St[dkb]); }
            RAWBAR();
        }
    }
    __syncthreads();
}

DI void p9_normgate(const Params& P, unsigned char* lds_, int gw, int ngw, int lane, int wid) {
    unsigned char* ws = P.ws;
    lptr tile = (lptr)lds_ + wid * 18432;
    const bf16_t* Z = (const bf16_t*)(ws + O_Z); bf16_t* OG = (bf16_t*)P.out + (size_t)M * 1024;
    const int r32 = lane & 31, hi = lane >> 5;
    for (int ch = gw; ch < 2048; ch += ngw) {
        const int h = ch & 7, bn = ch >> 3, b = bn >> 6, n = bn & 63; const size_t m0 = (size_t)b * S + 64 * n;
        LFENCE();
#pragma unroll 1
        for (int ib = 0; ib < 2; ++ib) {
            f32x16 o[4]; float ss[16];
#pragma unroll
            for (int eb = 0; eb < 4; ++eb) unpack16(o[eb], rawp(ws + O_DV, m0, h, (eb * 2 + ib) * 2048 + lane * 32));
#pragma unroll
            for (int r = 0; r < 16; ++r) { float s = o[0][r] * o[0][r] + o[1][r] * o[1][r] + o[2][r] * o[2][r] + o[3][r] * o[3][r];
                s += __shfl_xor(s, 1); s += __shfl_xor(s, 2); s += __shfl_xor(s, 4); s += __shfl_xor(s, 8); s += __shfl_xor(s, 16);
                ss[r] = rsqrtf(s * (1.f / 128.f) + 1e-6f); }
#pragma unroll
            for (int eb = 0; eb < 4; ++eb) { const float w = P.dn_norm_w[32 * eb + r32];
                lptr tp = tile + (32 * ib + 4 * hi) * 272 + (32 * eb + r32) * 2;
#pragma unroll
                for (int r = 0; r < 16; ++r) *(LAS bf16_t*)(tp + ((r & 3) + 8 * (r >> 2)) * 272) = (bf16_t)f2bf(o[eb][r] * ss[r] * w); }
        }
        LFENCE();
#pragma unroll 4
        for (int it = 0; it < 16; ++it) { const int idx = it * 64 + lane, row = idx >> 4, c16 = idx & 15;
            const size_t off = (m0 + row) * 1024 + h * 128 + c16 * 8;
            const u32x4 v = *(const LAS u32x4*)(tile + row * 272 + c16 * 16), z = *(const u32x4*)(Z + off);
            u32x4 o; o.x = pk2(bflo(v.x) * silu(bflo(z.x)), bfhi(v.x) * silu(bfhi(z.x))); o.y = pk2(bflo(v.y) * silu(bflo(z.y)), bfhi(v.y) * silu(bfhi(z.y)));
            o.z = pk2(bflo(v.z) * silu(bflo(z.z)), bfhi(v.z) * silu(bfhi(z.z))); o.w = pk2(bflo(v.w) * silu(bflo(z.w)), bfhi(v.w) * silu(bfhi(z.w)));
            *(u32x4*)(OG + off) = o; }
    }
}
DI void ln_rows(const float* __restrict__ in, float* __restrict__ outf, bf16_t* __restrict__ outb, const float* g, const float* bta, int gw, int ngw, int lane) {
    for (int m = gw; m < M; m += ngw) {
        const f32x4* xr = (const f32x4*)(in + (size_t)m * D) + lane;
        f32x4 v[4]; float s = 0.f;
#pragma unroll
        for (int j = 0; j < 4; ++j) { v[j] = xr[64 * j]; s += (v[j][0] + v[j][1]) + (v[j][2] + v[j][3]); }
        const float mean = wave_sum(s) * (1.f / D); float s2 = 0.f;
#pragma unroll
        for (int j = 0; j < 4; ++j) { v[j] = v[j] - mean; s2 += (v[j][0] * v[j][0] + v[j][1] * v[j][1]) + (v[j][2] * v[j][2] + v[j][3] * v[j][3]); }
        const float rstd = rsqrtf(wave_sum(s2) * (1.f / D) + 1e-5f);
#pragma unroll
        for (int j = 0; j < 4; ++j) { const int c = 4 * lane + 256 * j; const f32x4 gg = *(const f32x4*)(g + c), bb = *(const f32x4*)(bta + c); const f32x4 o = v[j] * rstd * gg + bb;
            *(f32x4*)(outf + (size_t)m * D + c) = o; if (outb) st4(outb + (size_t)m * D + c, o); }
    }
}

#define XB_TMO      128
#define XB_XCNT(j)  (256  + 64 * (j))
#define XB_XSUB(j)  (1280 + 64 * (j))
#define XB_XGEN(j)  (2304 + 64 * (j))
#define XB_TOP      3328
#define XB_TOPGEN   3392
#define XCD_BAR_WORDS 3456
#define XB_SPIN_CAP (1u << 22)
DI unsigned xb_ld(unsigned* p)              { return __hip_atomic_load(p, __ATOMIC_RELAXED, __HIP_MEMORY_SCOPE_AGENT); }
DI unsigned xb_add(unsigned* p, unsigned v) { return __hip_atomic_fetch_add(p, v, __ATOMIC_RELAXED, __HIP_MEMORY_SCOPE_AGENT); }
DI unsigned xb_xcc_id() { return (unsigned)__builtin_amdgcn_s_getreg((3 << 11) | 20) & 0xFu; }
#define XB_SPIN(cond, bar) do { unsigned _sp = 0; while (cond) { __builtin_amdgcn_s_sleep(1); \
    if ((++_sp & 255u) == 0u) { if (xb_ld(&(bar)[XB_TMO])) break; if (_sp > XB_SPIN_CAP) { atomicAdd(&(bar)[XB_TMO], 1u); break; } } } } while (0)
struct XcdBarrier { unsigned* bar; unsigned x; volatile LAS unsigned* st; };
DI XcdBarrier xcd_barrier_post(unsigned* bar, volatile LAS unsigned* st) {
    XcdBarrier b; b.bar = bar; b.x = xb_xcc_id(); b.st = st;
    if (threadIdx.x == 0) (void)xb_add(&bar[XB_XCNT(b.x)], 1u);
    return b;
}
DI void xcd_barrier_complete(unsigned* bar, unsigned x, unsigned& nloc, unsigned& nx) {
    const unsigned G = gridDim.x * gridDim.y * gridDim.z;
    unsigned sum, cnt, mine, sp = 0u;
    for (;;) {
        sum = 0u; cnt = 0u; mine = 0u;
#pragma unroll
        for (unsigned j = 0; j < 16; ++j) { const unsigned c = xb_ld(&bar[XB_XCNT(j)]); sum += c; cnt += (c > 0u) ? 1u : 0u; mine = (j == x) ? c : mine; }
        if (sum == G) break;
        __builtin_amdgcn_s_sleep(1);
        if ((++sp & 255u) == 0u) { if (xb_ld(&bar[XB_TMO])) break; if (sp > XB_SPIN_CAP) { atomicAdd(&bar[XB_TMO], 1u); break; } }
    }
    nloc = mine > 0u ? mine : 1u; nx = cnt > 0u ? cnt : 1u;
}
DI void xcd_barrier(const XcdBarrier& b) {
    asm volatile("s_waitcnt vmcnt(0) lgkmcnt(0)" ::: "memory");
    __syncthreads();
    if (threadIdx.x == 0) {
        unsigned* bar = b.bar;
        __builtin_amdgcn_s_waitcnt(0);
        unsigned nloc = b.st[0], nx = b.st[1];
        if (nloc == 0u) { xcd_barrier_complete(bar, b.x, nloc, nx); b.st[0] = nloc; b.st[1] = nx; }
        const unsigned old = xb_add(&bar[XB_XSUB(b.x)], 1u);
        const unsigned gen = old / nloc;
        if (old + 1u == (gen + 1u) * nloc) {
            __builtin_amdgcn_fence(__ATOMIC_RELEASE, "agent");
            asm volatile("s_waitcnt vmcnt(0)" ::: "memory");
            const unsigned og = xb_add(&bar[XB_TOP], 1u);
            const unsigned tg = og / nx;
            if (og + 1u == (tg + 1u) * nx) xb_add(&bar[XB_TOPGEN], 1u);
            else XB_SPIN(xb_ld(&bar[XB_TOPGEN]) == tg, bar);
            __builtin_amdgcn_fence(__ATOMIC_ACQUIRE, "agent");
            xb_add(&bar[XB_XGEN(b.x)], 1u);
            asm volatile("s_waitcnt vmcnt(0)" ::: "memory");
        } else {
            XB_SPIN(xb_ld(&bar[XB_XGEN(b.x)]) == gen, bar);
            __builtin_amdgcn_fence(__ATOMIC_ACQUIRE, "agent");
            asm volatile("s_waitcnt vmcnt(0)" ::: "memory");
        }
    }
    __syncthreads();
}

constexpr int NPH = 13;
__global__ void __launch_bounds__(NTHREADS, 2) mega(Params P) {
    extern __shared__ __attribute__((aligned(16))) unsigned char lds[];
    cg::grid_group grid = cg::this_grid();
    const int tid = threadIdx.x, lane = tid & 63, wid = __builtin_amdgcn_readfirstlane(tid >> 6);
    const int gw = blockIdx.x * NWAVES + wid, ngw = gridDim.x * NWAVES;
#define gt ((size_t)blockIdx.x * NTHREADS + threadIdx.x)
#define ngt ((size_t)gridDim.x * NTHREADS)
    unsigned char* ws = P.ws;
    bf16_t* WIN = (bf16_t*)(ws + W_IN);
    bf16_t* XB = (bf16_t*)P.out;
    { volatile LAS unsigned* st_ = (volatile LAS unsigned*)((lptr)lds + 147456); if (tid == 0) { st_[0] = 0u; st_[1] = 0u; } }
    __syncthreads();
    const XcdBarrier xbar = xcd_barrier_post((unsigned*)(ws + O_BAR + 4096), (volatile LAS unsigned*)((lptr)lds + 147456));
#define PH_BEGIN(k) if (P.ph_lo <= (k) && (k) < P.ph_hi) {
#define PH_END(k) if ((k) + 1 < P.ph_hi) { if (P.ph_hi > 1000) grid.sync(); else xcd_barrier(xbar); } }
    PH_BEGIN(0) {
            cvt_rows(P.x, XB, (size_t)M * D / 8, gt, ngt);
            transpose_mat(P.w_in, 1024, 6864, WIN, NA, 1, gw, ngw, lane, lds);
        } PH_END(0)
    PH_BEGIN(1) { EpiProjA E{(bf16_t*)(ws + O_PROJA), (float*)(ws + O_AB)}; gemm_run(lds, XB, 1024, WIN, 1024, M, NA, 1024, E); } PH_END(1)
    PH_BEGIN(2) { p2_tokens(P, gw, ngw, lane);
            __syncthreads();
            transpose_rest(P, gw, ngw, lane, lds);
        } PH_END(2)
    PH_BEGIN(3) { delta_A(P, lds, gw, ngw, lane, wid);
                  __syncthreads();
                  { EpiQ E{(bf16_t*)(ws + O_Q)}; gemm_run(lds, (const bf16_t*)(ws + O_CQ), 384, (const bf16_t*)(ws + W_UQ), 384, M, 1536, 384, E); }
                  { EpiKV E{(bf16_t*)(ws + O_KN), (bf16_t*)(ws + O_V)}; gemm_run(lds, (const bf16_t*)(ws + O_CKV), 256, (const bf16_t*)(ws + W_UKV), 256, M, 2048, 256, E); } } PH_END(3)
    PH_BEGIN(4) {
        unsigned* ctl = (unsigned*)(ws + O_BAR);
        if (blockIdx.x < 32) { for (int u = blockIdx.x; u < 32; u += gridDim.x) delta_B2(P, lds, u);
            if (tid == 0) { asm volatile("s_waitcnt vmcnt(0)" ::: "memory"); __hip_atomic_fetch_add(ctl + 64 * 9, gridDim.x < 32 ? 32u / gridDim.x : 1u, __ATOMIC_RELEASE, __HIP_MEMORY_SCOPE_AGENT); } }
        attn_queue(P, lds, ctl + 64);
        if (tid == 0) { const unsigned want = gridDim.x < 32 ? (32u / gridDim.x) * gridDim.x : 32u; while (__hip_atomic_load(ctl + 64 * 9, __ATOMIC_RELAXED, __HIP_MEMORY_SCOPE_AGENT) < want) __builtin_amdgcn_s_sleep(2); }
        __syncthreads();
        cvt_rows(P.x, XB, (size_t)M * D / 8, gt, ngt);
    } PH_END(4)
    PH_BEGIN(5) { EpiZG E{(bf16_t*)(ws + O_Z), (bf16_t*)(ws + O_GD), (bf16_t*)(ws + O_GM)}; gemm_run(lds, XB, 1024, WIN + (size_t)NA * 1024, 1024, M, NB, 1024, E); } PH_END(5)
    PH_BEGIN(6) p9_normgate(P, lds, gw, ngw, lane, wid); PH_END(6)
    PH_BEGIN(7) { { EpiYdn E{(bf16_t*)(ws + O_GD)}; gemm_run(lds, (const bf16_t*)P.out + (size_t)M * 1024, 1024, (const bf16_t*)(ws + W_BRDN), 1024, M, 1024, 1024, E); }
                  asm volatile("s_waitcnt vmcnt(0)" ::: "memory");
                  { EpiYmla E{(const bf16_t*)(ws + O_GD), (bf16_t*)(ws + O_GM)}; gemm_run(lds, (const bf16_t*)(ws + O_Q), 1536, (const bf16_t*)(ws + W_BRMLA), 1536, M, 1024, 1536, E); } } PH_END(7)
    PH_BEGIN(8) { EpiWo E{P.x, P.out}; gemm_run(lds, (const bf16_t*)(ws + O_GM), 1024, (const bf16_t*)(ws + W_O), 1024, M, 1024, 1024, E); } PH_END(8)
    PH_BEGIN(9) { ln_rows(P.out, (float*)(ws + O_H1), (bf16_t*)(ws + O_H1B), P.ln1_g, P.ln1_b, gw, ngw, lane);
                  cvt_rows(P.p, (bf16_t*)(ws + O_PB), (size_t)M * 256 / 8, gt, ngt); } PH_END(9)
    PH_BEGIN(10) { { EpiFfnIn E{(bf16_t*)(ws + O_ACT)}; gemm_run(lds, (const bf16_t*)(ws + O_H1B), 1024, (const bf16_t*)(ws + W_FFNIN), 1024, M, 5632, 1024, E); }
                   { EpiSg E{(bf16_t*)P.out}; gemm_run(lds, (const bf16_t*)(ws + O_H1B), 1024, (const bf16_t*)(ws + W_PG), 1024, M, 1024, 1024, E); }
                   { EpiStore E{(bf16_t*)P.out + (size_t)M * 1024, 1024}; gemm_run(lds, (const bf16_t*)(ws + O_PB), 256, (const bf16_t*)(ws + W_PLE), 256, M, 1024, 256, E); } } PH_END(10)
    PH_BEGIN(11) { EpiFfnOut E{(float*)(ws + O_H1), (const bf16_t*)P.out, (const bf16_t*)P.out + (size_t)M * 1024}; gemm_run(lds, (const bf16_t*)(ws + O_ACT), FF, (const bf16_t*)(ws + W_FFNOUT), FF, M, 1024, FF, E); } PH_END(11)
    PH_BEGIN(12) ln_rows((const float*)(ws + O_H1), P.out, nullptr, P.ln2_g, P.ln2_b, gw, ngw, lane); PH_END(12)
}

extern "C" void kernel_launch(void* const* d_in, const int* in_sizes, int n_in, void* d_out, int out_size, void* d_ws, size_t ws_size, hipStream_t stream) {
    static int grid = 0;
    if (grid == 0) {
        int dev = 0, cus = 0, per_cu = 0;
        (void)hipGetDevice(&dev);
        (void)hipDeviceGetAttribute(&cus, hipDeviceAttributeMultiprocessorCount, dev);
        (void)hipFuncSetAttribute((const void*)mega, hipFuncAttributeMaxDynamicSharedMemorySize, LDS_BYTES);
        (void)hipOccupancyMaxActiveBlocksPerMultiprocessor(&per_cu, (const void*)mega, NTHREADS, LDS_BYTES);
        if (per_cu < 1) per_cu = 1;
        grid = cus * per_cu;
        if (ws_size < 256 * MiB) { fprintf(stderr, "workspace too small: %zu\n", ws_size); grid = -1; }
    }
    if (grid < 0) return;
    (void)hipMemsetAsync((unsigned char*)d_ws + O_BAR, 0, 4096 + 16384, stream);
    Params P{};
    const float** pf = (const float**)&P;
    for (int i = 0; i < 24; ++i) pf[i] = (const float*)d_in[i];
    P.out = (float*)d_out; P.ws = (unsigned char*)d_ws;
#if NLAUNCH == 1
    P.ph_lo = 0; P.ph_hi = NPH;
    { void* args[] = {&P}; hipError_t e = hipLaunchCooperativeKernel((const void*)mega, dim3(grid), dim3(NTHREADS), args, LDS_BYTES, stream);
      if (e != hipSuccess) fprintf(stderr, "cooperative launch failed: %s\n", hipGetErrorString(e)); }
#else
    for (int ph = 0; ph < NPH; ++ph) { P.ph_lo = ph; P.ph_hi = ph + 1; void* args[] = {&P};
        hipError_t e = hipLaunchCooperativeKernel((const void*)mega, dim3(grid), dim3(NTHREADS), args, LDS_BYTES, stream);
        if (e != hipSuccess) { fprintf(stderr, "cooperative launch failed: %s\n", hipGetErrorString(e)); break; } }
#endif
}
```

```cpp
#include <hip/hip_runtime.h>
#include <hip/hip_cooperative_groups.h>
#include <cstdint>
#include <cstdio>
namespace cg = cooperative_groups;

#define DI __device__ __forceinline__
typedef unsigned short bf16_t;
typedef short bf16x8 __attribute__((ext_vector_type(8)));
typedef float f32x4 __attribute__((ext_vector_type(4)));
typedef float f32x2 __attribute__((ext_vector_type(2)));
typedef unsigned u32x4 __attribute__((ext_vector_type(4)));
typedef unsigned u32x2 __attribute__((ext_vector_type(2)));

#ifndef NLAUNCH
#define NLAUNCH 1
#endif

constexpr int Bn = 4, S = 4096, D = 1024, M = Bn * S;
constexpr int NA = 3840, NB = 3072, NIN = NA + NB;
constexpr int FF = 2816;
constexpr int NTHREADS = 512, NWAVES = 8;
constexpr int LDS_BYTES = 147456 + 64;
constexpr float ALPHA = 1.189207115002721f;
constexpr float C2 = 0.07216878364870322f * 1.4426950408889634f;

constexpr size_t MiB = 1u << 20;
constexpr size_t W_IN = 0, W_UQ = W_IN + (size_t)NIN * 1024 * 2, W_UKV = W_UQ + (size_t)1536 * 384 * 2, W_BRDN = W_UKV + (size_t)2048 * 256 * 2,
                 W_BRMLA = W_BRDN + 2 * MiB, W_O = W_BRMLA + 3 * MiB, W_FFNIN = W_O + 2 * MiB, W_FFNOUT = W_FFNIN + (size_t)5632 * 1024 * 2,
                 W_PG = W_FFNOUT + (size_t)1024 * FF * 2, W_PLE = W_PG + 2 * MiB, W_END = W_PLE + (size_t)1024 * 256 * 2;
static_assert(W_END <= 41 * MiB + 768 * 1024, "weights");
constexpr size_t O_BAR = 41 * MiB + 768 * 1024;
constexpr size_t O_AB = 42 * MiB, O_EGL = O_AB, O_BETA = 43 * MiB, O_GG = 43 * MiB + MiB / 2, O_CQ = 44 * MiB, O_PB = O_CQ, O_CKV = 56 * MiB, O_KR = 64 * MiB;
constexpr size_t ARENA = 66 * MiB;
constexpr size_t O_PROJA = ARENA, O_DV = 224 * MiB;
constexpr size_t O_WT = ARENA, O_INTRA = ARENA + 32 * MiB, O_Q = ARENA + 44 * MiB, O_KN = ARENA + 92 * MiB, O_V = ARENA + 124 * MiB;
constexpr size_t O_Z = ARENA, O_GD = O_KN, O_GM = O_V;
constexpr size_t O_H1 = ARENA, O_H1B = ARENA + 64 * MiB, O_ACT = ARENA + 96 * MiB;
static_assert(O_V + 32 * MiB <= O_DV && O_PROJA + 120 * MiB <= O_DV && O_ACT + 88 * MiB <= 256 * MiB && O_DV + 32 * MiB <= 256 * MiB, "ws map");

struct Params {
    const float* x; const float* p; const int* pos; const float* w_in; const float* conv_w; const float* a_log; const float* dt_bias; const float* dn_norm_w;
    const float* q_norm_w; const float* w_uq; const float* kv_norm_w; const float* w_uk; const float* w_uv; const float* w_br_dn; const float* w_br_mla; const float* w_o;
    const float* ln1_g; const float* ln1_b; const float* w_ffn_in; const float* w_ffn_out; const float* w_ple; const float* w_ple_gate; const float* ln2_g; const float* ln2_b;
    float* out; unsigned char* ws; int ph_lo, ph_hi;
};

DI unsigned f2bf(float f) { unsigned u = __float_as_uint(f); return (u + 0x7fffu + ((u >> 16) & 1u)) >> 16; }
typedef __bf16 bf16x2_t __attribute__((ext_vector_type(2)));
DI unsigned pk2(float lo, float hi) { const f32x2 v = {lo, hi}; return __builtin_bit_cast(unsigned, __builtin_convertvector(v, bf16x2_t)); }
DI float bflo(unsigned u) { return __uint_as_float(u << 16); }
DI float bfhi(unsigned u) { return __uint_as_float(u & 0xffff0000u); }
DI float bf2f(bf16_t b) { return __uint_as_float(((unsigned)b) << 16); }
DI float sigm(float x) { return 1.f / (1.f + __expf(-x)); }
DI float silu(float x) { return x / (1.f + __expf(-x)); }
DI float wave_sum(float v) {
#pragma unroll
    for (int o = 1; o < 64; o <<= 1) v += __shfl_xor(v, o);
    return v;
}
DI float wave_max(float v) {
#pragma unroll
    for (int o = 1; o < 64; o <<= 1) v = fmaxf(v, __shfl_xor(v, o));
    return v;
}
DI void st4(bf16_t* p, f32x4 v) { u32x2 w; w.x = pk2(v[0], v[1]); w.y = pk2(v[2], v[3]); *(u32x2*)p = w; }
DI f32x4 ld4(const bf16_t* p) { const u32x2 w = *(const u32x2*)p; return (f32x4){bflo(w.x), bfhi(w.x), bflo(w.y), bfhi(w.y)}; }
DI void rope_cs(int pos, int i, float& c, float& s) {
    const float inv = exp2f(-(float)i * (13.287712379549449f / 32.f));
    const float ang = (float)pos * inv;
    const double a = (double)ang; const double k = rint(a * 0.15915494309189535); const float r = (float)(a - k * 6.283185307179586);
    c = __cosf(r); s = __sinf(r);
}

DI void transpose_item(const float* __restrict__ W, int K, int ldw, bf16_t* __restrict__ WT, int mode, int it, int lane, unsigned char* lds_) {
    typedef __attribute__((address_space(3))) float lfloat;
    lfloat* scr = (lfloat*)((__attribute__((address_space(3))) unsigned char*)lds_ + (threadIdx.x >> 6) * 8448);
    const int nkb = K / 64;
    {
        const int nb = it / nkb, kb = it % nkb, n = nb * 32 + (lane & 31), k0 = kb * 64;
        int sc = n;
        if (mode == 1) { if (n < 3072) sc = n; else if (n < 3792) sc = n + 1024; else if (n < 3840) sc = -1; else { const int nn = n - 3840; sc = nn < 1024 ? nn + 3072 : nn + 3792; } }
        else if (mode == 6) { sc = n < 1024 ? n + 3072 : n + 3792; }
        else if (mode == 3) { const int t = n >> 8, w = n & 255; sc = w < 128 ? 128 * t + w : 2816 + 128 * t + (w - 128); }
        else if (mode == 4) { const int h = n / 192, d = n % 192; if (d >= 128) { const int r = d - 128; sc = h * 192 + 128 + (r >> 1) + 32 * (r & 1); } }
        int kr = k0; if (mode == 5) { const int hh = kb / 3, part = kb % 3; kr = hh * 128 + part * 64; if (part == 2) sc = -1; }
#pragma unroll 16
        for (int i = 0; i < 32; ++i) { const int kk = 2 * i + (lane >> 5); scr[kk * 33 + (lane & 31)] = sc >= 0 ? W[(size_t)(kr + kk) * ldw + sc] : 0.f; }
        asm volatile("s_waitcnt lgkmcnt(0)" ::: "memory");
        const int c = lane & 7;
#pragma unroll
        for (int j = 0; j < 4; ++j) { const int nn = (lane >> 3) + 8 * j; const lfloat* s = scr + (8 * c) * 33 + nn;
            u32x4 o; o.x = pk2(s[0 * 33], s[1 * 33]); o.y = pk2(s[2 * 33], s[3 * 33]); o.z = pk2(s[4 * 33], s[5 * 33]); o.w = pk2(s[6 * 33], s[7 * 33]);
            *(u32x4*)(WT + (size_t)(nb * 32 + nn) * K + k0 + 8 * c) = o; }
        asm volatile("s_waitcnt lgkmcnt(0)" ::: "memory");
    }
}
DI void transpose_mat(const float* __restrict__ W, int K, int ldw, bf16_t* __restrict__ WT, int nrows, int mode, int gw, int ngw, int lane, unsigned char* lds_) {
    const int nitems = (nrows / 32) * (K / 64);
    for (int it = gw; it < nitems; it += ngw) transpose_item(W, K, ldw, WT, mode, it, lane, lds_);
}
DI void transpose_rest(const Params& P, int gw, int ngw, int lane, unsigned char* lds_) {
    unsigned char* ws = P.ws;
    constexpr int I0 = (1536 / 32) * (384 / 64), I1 = I0 + 2 * (1024 / 32) * (256 / 64), I2 = I1 + (NB / 32) * 16, I3 = I2 + 32 * 16, I4 = I3 + 32 * 24, I5 = I4 + 32 * 16,
                  I6 = I5 + (5632 / 32) * 16, I7 = I6 + 32 * (FF / 64), I8 = I7 + 32 * 16, I9 = I8 + 32 * 4;
    for (int g = gw; g < I9; g += ngw) {
        if (g < I0) transpose_item(P.w_uq, 384, 1536, (bf16_t*)(ws + W_UQ), 4, g, lane, lds_);
        else if (g < I1) { const int q = g - I0; if (q < 128) transpose_item(P.w_uk, 256, 1024, (bf16_t*)(ws + W_UKV), 0, q, lane, lds_); else transpose_item(P.w_uv, 256, 1024, (bf16_t*)(ws + W_UKV) + (size_t)1024 * 256, 0, q - 128, lane, lds_); }
        else if (g < I2) transpose_item(P.w_in, 1024, 6864, (bf16_t*)(ws + W_IN) + (size_t)NA * 1024, 6, g - I1, lane, lds_);
        else if (g < I3) transpose_item(P.w_br_dn, 1024, 1024, (bf16_t*)(ws + W_BRDN), 0, g - I2, lane, lds_);
        else if (g < I4) transpose_item(P.w_br_mla, 1536, 1024, (bf16_t*)(ws + W_BRMLA), 5, g - I3, lane, lds_);
        else if (g < I5) transpose_item(P.w_o, 1024, 1024, (bf16_t*)(ws + W_O), 0, g - I4, lane, lds_);
        else if (g < I6) transpose_item(P.w_ffn_in, 1024, 5632, (bf16_t*)(ws + W_FFNIN), 3, g - I5, lane, lds_);
        else if (g < I7) transpose_item(P.w_ffn_out, FF, 1024, (bf16_t*)(ws + W_FFNOUT), 0, g - I6, lane, lds_);
        else if (g < I8) transpose_item(P.w_ple_gate, 1024, 1024, (bf16_t*)(ws + W_PG), 0, g - I7, lane, lds_);
        else transpose_item(P.w_ple, 256, 1024, (bf16_t*)(ws + W_PLE), 0, g - I8, lane, lds_);
    }
}
DI void cvt_rows(const float* __restrict__ src, bf16_t* __restrict__ dst, size_t n8, size_t gt, size_t ngt) {
#pragma unroll 4
    for (size_t i = gt; i < n8; i += ngt) { const f32x4 a = *(const f32x4*)(src + i * 8), b = *(const f32x4*)(src + i * 8 + 4);
        u32x4 o; o.x = pk2(a[0], a[1]); o.y = pk2(a[2], a[3]); o.z = pk2(b[0], b[1]); o.w = pk2(b[2], b[3]); *(u32x4*)(dst + i * 8) = o; }
}

namespace pg8 {
#define PG8_LAS __attribute__((address_space(3)))
constexpr int BM = 256, BK = 64, HALF = 128, HTB = HALF * BK * 2, STAGE_BYTES = 8 * HTB, NXCD = 8, WGM = 8;
DI int lds_byte(int r, int c) { const int st = (r >> 4) * 2 + (c >> 5), rr = r & 15, cc = c & 31, ob = rr * 64 + cc * 2; return st * 1024 + (ob ^ (((ob >> 9) & 1) << 5)); }
DI void stage_rc(int b, int& R, int& C) { const int st = b / 1024, sb = b % 1024, swz = sb ^ (((sb >> 9) & 1) << 5); R = (st >> 1) * 16 + swz / 64; C = (st & 1) * 32 + (swz % 64) / 2; }
struct Unit { int pm, pn; };
struct Gemm { const bf16_t* A; const bf16_t* Bt; int M, N, K, lda, ldb; };
struct StaticOrder {
    int nM, nN, nwg, G, c;
    DI void init(int M_, int N_, int G_, int c_) { nM = M_ / BM; nN = N_ / BM; nwg = nM * nN; G = G_; c = c_; }
    DI bool next(int i, Unit& u) const {
        const long L = (long)i * G + c; if (L >= nwg) return false;
        int wgid = (int)L; { const int q = nwg / NXCD, r = nwg % NXCD, xcd = wgid % NXCD, off = wgid / NXCD; wgid = (xcd < r ? xcd * (q + 1) : r * (q + 1) + (xcd - r) * q) + off; }
        const int nig = WGM * nN, gid = wgid / nig, fm = gid * WGM, gsz = (nM - fm) < WGM ? (nM - fm) : WGM;
        u.pm = fm + ((wgid % nig) % gsz); u.pn = (wgid % nig) / gsz; return true;
    }
};
template <class Epi>
DI void gemm_phase(PG8_LAS unsigned char* lds, const Gemm g, const StaticOrder& S, const Epi& E) {
    const int tid = threadIdx.x, wid = __builtin_amdgcn_readfirstlane(tid >> 6), lane = tid & 63, wr = wid >> 2, wc = wid & 3, fr = lane & 15, fq = lane >> 4;
    const int K = g.K, nt = K / BK;
    unsigned voffA[2], voffB[2];
#pragma unroll
    for (int i = 0; i < 2; ++i) { int R, C; stage_rc(tid * 16 + i * 8192, R, C); voffA[i] = (unsigned)(R * g.lda + C) * 2u; voffB[i] = (unsigned)(R * g.ldb + C) * 2u; }
    const size_t kstep = (size_t)(BK * 2);
    const size_t hstepA = (size_t)HALF * g.lda * 2, hstepB = (size_t)HALF * g.ldb * 2;
    const size_t tstepA = 2 * hstepA, tstepB = 2 * hstepB;
    const unsigned ldsw = (unsigned)wid * 1024u;
    const int aoff = lds_byte(wr * 64 + fr, fq * 8), boff = lds_byte(wc * 32 + fr, fq * 8);
#define PG8_SA(b, h) (((b) * 2 + (h)) * HTB)
#define PG8_SB(b, h) ((4 + (b) * 2 + (h)) * HTB)
#define PG8_STAGE(bufoff, gbase, voff) do { _Pragma("unroll") for (int _i = 0; _i < 2; ++_i) \
        __builtin_amdgcn_global_load_lds((const unsigned*)((const char*)(gbase) + (voff)[_i]), (PG8_LAS unsigned*)(lds + (bufoff) + ldsw + _i * 8192), 16, 0, 0); } while (0)
#define PG8_LDA(dst, b, h) do { _Pragma("unroll") for (int m = 0; m < 4; ++m) _Pragma("unroll") for (int k = 0; k < 2; ++k) dst[m][k] = *(const PG8_LAS bf16x8*)(lds + PG8_SA(b, h) + aoff + m * 2048 + k * 1024); } while (0)
#define PG8_LDB(dst, b, h) do { _Pragma("unroll") for (int n = 0; n < 2; ++n) _Pragma("unroll") for (int k = 0; k < 2; ++k) dst[n][k] = *(const PG8_LAS bf16x8*)(lds + PG8_SB(b, h) + boff + n * 2048 + k * 1024); } while (0)
#define PG8_MMA(ai, bj, At, Bt) do { __builtin_amdgcn_s_setprio(1); _Pragma("unroll") for (int m = 0; m < 4; ++m) _Pragma("unroll") for (int n = 0; n < 2; ++n) _Pragma("unroll") for (int k = 0; k < 2; ++k) \
        acc[ai][bj][m][n] = __builtin_amdgcn_mfma_f32_16x16x32_bf16(Bt[n][k], At[m][k], acc[ai][bj][m][n], 0, 0, 0); __builtin_amdgcn_s_setprio(0); } while (0)
#define PG8_WAIT_V(n) asm volatile("s_waitcnt vmcnt(" #n ")" ::: "memory")
#define PG8_WAIT_L(n) asm volatile("s_waitcnt lgkmcnt(" #n ")" ::: "memory")
#define PG8_BAR __builtin_amdgcn_s_barrier()
#define PG8_SCHED __builtin_amdgcn_sched_barrier(0)
    Unit cur, nxt; int ui = 0;
    if (!S.next(0, cur)) return;
    f32x4 acc[2][2][4][2];
#pragma unroll
    for (int a = 0; a < 2; ++a)
#pragma unroll
        for (int b = 0; b < 2; ++b)
#pragma unroll
            for (int m = 0; m < 4; ++m)
#pragma unroll
                for (int n = 0; n < 2; ++n) acc[a][b][m][n] = (f32x4){0.f, 0.f, 0.f, 0.f};
    bf16x8 At[4][2], B0[2][2], B1[2][2];
    const char* cA = (const char*)g.A + (size_t)cur.pm * tstepA; const char* cB = (const char*)g.Bt + (size_t)cur.pn * tstepB;
    PG8_STAGE(PG8_SB(0, 0), cB, voffB); PG8_STAGE(PG8_SB(0, 1), cB + hstepB, voffB); PG8_STAGE(PG8_SA(0, 0), cA, voffA); PG8_STAGE(PG8_SA(0, 1), cA + hstepA, voffA);
    if (wr == 1) PG8_BAR;
    PG8_WAIT_V(2); PG8_BAR;
    PG8_STAGE(PG8_SB(1, 0), cB + kstep, voffB); PG8_STAGE(PG8_SA(1, 0), cA + kstep, voffA); PG8_STAGE(PG8_SB(1, 1), cB + hstepB + kstep, voffB);
    PG8_WAIT_V(6); PG8_BAR;
    for (;;) {
        const bool has_next = S.next(ui + 1, nxt);
        const char* nA = has_next ? (const char*)g.A + (size_t)nxt.pm * tstepA : cA; const char* nB = has_next ? (const char*)g.Bt + (size_t)nxt.pn * tstepB : cB;
#pragma unroll 1
        for (int t = 0; t < nt; t += 2) {
            const bool last = (t == nt - 2);
            const char* a1 = cA + (size_t)(t + 1) * kstep;
            const char* a2 = last ? nA : cA + (size_t)(t + 2) * kstep; const char* b2 = last ? nB : cB + (size_t)(t + 2) * kstep;
            const char* a3 = a2 + kstep; const char* b3 = b2 + kstep;
            PG8_LDB(B0, 0, 0); PG8_LDB(B1, 0, 1); PG8_SCHED; PG8_LDA(At, 0, 0); PG8_STAGE(PG8_SA(1, 1), a1 + hstepA, voffA);
            PG8_WAIT_V(8); PG8_WAIT_L(0); PG8_BAR; PG8_MMA(0, 0, At, B0); PG8_MMA(0, 1, At, B1); PG8_BAR; PG8_SCHED;
            PG8_LDA(At, 0, 1); PG8_STAGE(PG8_SB(0, 0), b2, voffB); PG8_STAGE(PG8_SB(0, 1), b2 + hstepB, voffB); PG8_STAGE(PG8_SA(0, 0), a2, voffA);
            PG8_WAIT_V(8); PG8_WAIT_L(0); PG8_BAR; PG8_MMA(1, 0, At, B0); PG8_MMA(1, 1, At, B1); PG8_BAR; PG8_SCHED;
            PG8_LDB(B0, 1, 0); PG8_LDB(B1, 1, 1); PG8_SCHED; PG8_LDA(At, 1, 0); PG8_STAGE(PG8_SA(0, 1), a2 + hstepA, voffA);
            PG8_WAIT_V(8); PG8_WAIT_L(0); PG8_BAR; PG8_MMA(0, 0, At, B0); PG8_MMA(0, 1, At, B1); PG8_BAR; PG8_SCHED;
            PG8_LDA(At, 1, 1); PG8_STAGE(PG8_SB(1, 0), b3, voffB); PG8_STAGE(PG8_SB(1, 1), b3 + hstepB, voffB); PG8_STAGE(PG8_SA(1, 0), a3, voffA);
            PG8_WAIT_V(8); PG8_WAIT_L(0); PG8_BAR; PG8_MMA(1, 0, At, B0); PG8_MMA(1, 1, At, B1); PG8_BAR; PG8_SCHED;
        }
        if (wr == 0) PG8_BAR;
        {
            const int row0 = cur.pm * BM + wr * 64 + fr, col0 = cur.pn * BM + wc * 32 + 4 * fq;
#pragma unroll
            for (int ai = 0; ai < 2; ++ai)
#pragma unroll
                for (int m = 0; m < 4; ++m)
#pragma unroll
                    for (int n = 0; n < 2; ++n) E(row0 + ai * HALF + m * 16, col0 + n * 16, acc[ai][0][m][n], acc[ai][1][m][n]);
        }
        if (!has_next) break;
#pragma unroll
        for (int a = 0; a < 2; ++a)
#pragma unroll
            for (int b = 0; b < 2; ++b)
#pragma unroll
                for (int m = 0; m < 4; ++m)
#pragma unroll
                    for (int n = 0; n < 2; ++n) acc[a][b][m][n] = (f32x4){0.f, 0.f, 0.f, 0.f};
        cur = nxt; cA = nA; cB = nB; ++ui;
        if (wr == 1) PG8_BAR;
    }
    PG8_WAIT_V(0);
    PG8_BAR;
#undef PG8_SA
#undef PG8_SB
#undef PG8_STAGE
#undef PG8_LDA
#undef PG8_LDB
#undef PG8_MMA
#undef PG8_WAIT_V
#undef PG8_WAIT_L
#undef PG8_BAR
#undef PG8_SCHED
}
}
template <class Epi>
DI void gemm_run(unsigned char* lds, const bf16_t* A, int lda, const bf16_t* Bt, int ldb, int Mm, int N, int K, const Epi& E) {
    pg8::Gemm g{A, Bt, Mm, N, K, lda, ldb}; pg8::StaticOrder S; S.init(Mm, N, (int)gridDim.x, (int)blockIdx.x);
    pg8::gemm_phase((PG8_LAS unsigned char*)lds, g, S, E);
}

struct EpiProjA { bf16_t* O; float* AB;
    DI void operator()(int r, int c, f32x4 a, f32x4 b) const { bf16_t* o = O + (size_t)r * NA + c; st4(o, a); st4(o + 128, b);
        if (c >= 3072 && c < 3088) *(f32x4*)(AB + (size_t)r * 16 + (c - 3072)) = a; } };
struct EpiStore { bf16_t* O; int ldo;
    DI void operator()(int r, int c, f32x4 a, f32x4 b) const { bf16_t* o = O + (size_t)r * ldo + c; st4(o, a); st4(o + 128, b); } };
struct EpiQ { bf16_t* O;
    DI void operator()(int r, int c, f32x4 a, f32x4 b) const { bf16_t* o = O + (size_t)r * 1536 + c; st4(o, a * C2); st4(o + 128, b * C2); } };
struct EpiKV { bf16_t* KN; bf16_t* V;
    DI void one(int r, int c, f32x4 v) const { if (c < 1024) st4(KN + (size_t)r * 1024 + c, v); else st4(V + (size_t)r * 1024 + c - 1024, v); }
    DI void operator()(int r, int c, f32x4 a, f32x4 b) const { one(r, c, a); one(r, c + 128, b); } };
struct EpiZG { bf16_t* Z; bf16_t* GD; bf16_t* GM;
    DI void one(int r, int c, f32x4 v) const { bf16_t* o = c < 1024 ? Z + c : (c < 2048 ? GD + (c - 1024) : GM + (c - 2048)); st4(o + (size_t)r * 1024, v); }
    DI void operator()(int r, int c, f32x4 a, f32x4 b) const { one(r, c, a); one(r, c + 128, b); } };
struct EpiYdn { bf16_t* GD;
    DI void one(int r, int c, f32x4 v) const { bf16_t* g = GD + (size_t)r * 1024 + c; const f32x4 gv = ld4(g);
        st4(g, (f32x4){sigm(gv[0]) * v[0], sigm(gv[1]) * v[1], sigm(gv[2]) * v[2], sigm(gv[3]) * v[3]}); }
    DI void operator()(int r, int c, f32x4 a, f32x4 b) const { one(r, c, a); one(r, c + 128, b); } };
struct EpiYmla { const bf16_t* GD; bf16_t* GM;
    DI void one(int r, int c, f32x4 v) const { bf16_t* g = GM + (size_t)r * 1024 + c; const f32x4 gv = ld4(g), tv = ld4(GD + (size_t)r * 1024 + c);
        st4(g, (f32x4){tv[0] + sigm(gv[0]) * v[0], tv[1] + sigm(gv[1]) * v[1], tv[2] + sigm(gv[2]) * v[2], tv[3] + sigm(gv[3]) * v[3]}); }
    DI void operator()(int r, int c, f32x4 a, f32x4 b) const { one(r, c, a); one(r, c + 128, b); } };
struct EpiWo { const float* x; float* T1;
    DI void one(int r, int c, f32x4 v) const { const size_t o = (size_t)r * D + c; *(f32x4*)(T1 + o) = *(const f32x4*)(x + o) * ALPHA + v; }
    DI void operator()(int r, int c, f32x4 a, f32x4 b) const { one(r, c, a); one(r, c + 128, b); } };
struct EpiFfnIn { bf16_t* ACT;
    DI void operator()(int r, int c, f32x4 a, f32x4 b) const { const int t = c >> 8, j = c & 255;
        st4(ACT + (size_t)r * FF + 128 * t + j, (f32x4){silu(a[0]) * b[0], silu(a[1]) * b[1], silu(a[2]) * b[2], silu(a[3]) * b[3]}); } };
struct EpiSg { bf16_t* SG;
    DI void one(int r, int c, f32x4 v) const { st4(SG + (size_t)r * D + c, (f32x4){sigm(v[0]), sigm(v[1]), sigm(v[2]), sigm(v[3])}); }
    DI void operator()(int r, int c, f32x4 a, f32x4 b) const { one(r, c, a); one(r, c + 128, b); } };
struct EpiFfnOut { float* H1; const bf16_t* SG; const bf16_t* PLE0;
    DI void one(int r, int c, f32x4 v) const { const size_t o = (size_t)r * D + c; *(f32x4*)(H1 + o) = *(const f32x4*)(H1 + o) * ALPHA + v + ld4(SG + o) * ld4(PLE0 + o); }
    DI void operator()(int r, int c, f32x4 a, f32x4 b) const { one(r, c, a); one(r, c + 128, b); } };

DI float sum16(float v) { v += __shfl_xor(v, 1); v += __shfl_xor(v, 2); v += __shfl_xor(v, 4); v += __shfl_xor(v, 8); return v; }
DI void unpack8(float* f, u32x4 u) { f[0] = bflo(u.x); f[1] = bfhi(u.x); f[2] = bflo(u.y); f[3] = bfhi(u.y); f[4] = bflo(u.z); f[5] = bfhi(u.z); f[6] = bflo(u.w); f[7] = bfhi(u.w); }
DI void p2_tokens(const Params& P, int gw, int ngw, int lane) {
    unsigned char* ws = P.ws;
    const bf16_t* PA = (const bf16_t*)(ws + O_PROJA); const float* AB = (const float*)(ws + O_AB);
    bf16_t* DQ = (bf16_t*)P.out; bf16_t* DK = DQ + (size_t)M * 1024; bf16_t* DV = (bf16_t*)(ws + O_DV);
    float* BETA = (float*)(ws + O_BETA); float* GG = (float*)(ws + O_GG);
    bf16_t* CQ = (bf16_t*)(ws + O_CQ); bf16_t* CKV = (bf16_t*)(ws + O_CKV); bf16_t* KR = (bf16_t*)(ws + O_KR);
    for (int it = gw; it < 6 * (M / 16); it += ngw) {
        const int seg = it % 6, m0 = (it / 6) * 16;
        const int c0 = seg * 512 + 8 * lane;
        float w[4][8];
#pragma unroll
        for (int i = 0; i < 4; ++i) { const f32x4 a = *(const f32x4*)(P.conv_w + i * 3072 + c0), b = *(const f32x4*)(P.conv_w + i * 3072 + c0 + 4);
            w[i][0] = a[0]; w[i][1] = a[1]; w[i][2] = a[2]; w[i][3] = a[3]; w[i][4] = b[0]; w[i][5] = b[1]; w[i][6] = b[2]; w[i][7] = b[3]; }
        float xw[3][8];
        const bool first = (m0 % S) == 0;
#pragma unroll
        for (int i = 0; i < 3; ++i) { u32x4 u = (u32x4){0u, 0u, 0u, 0u}; if (!first) u = *(const u32x4*)(PA + (size_t)(m0 - 3 + i) * NA + c0); unpack8(xw[i], u); }
        bf16_t* dst = (seg < 2 ? DQ : (seg < 4 ? DK : DV)) + (seg & 1) * 512 + 8 * lane;
        const float qs = seg < 2 ? 0.08838834764831845f : 1.f;
        for (int t = 0; t < 16; t += 4) {
            u32x4 un[4];
#pragma unroll
            for (int q = 0; q < 4; ++q) un[q] = *(const u32x4*)(PA + (size_t)(m0 + t + q) * NA + c0);
#pragma unroll
            for (int q = 0; q < 4; ++q) {
                float xc[8]; unpack8(xc, un[q]);
                float a[8]; float ss = 0.f;
#pragma unroll
                for (int j = 0; j < 8; ++j) { a[j] = silu(w[0][j] * xw[0][j] + w[1][j] * xw[1][j] + w[2][j] * xw[2][j] + w[3][j] * xc[j]); ss += a[j] * a[j]; }
                if (seg < 4) { const float r = rsqrtf(sum16(ss) + 1e-6f) * qs;
#pragma unroll
                    for (int j = 0; j < 8; ++j) a[j] *= r; }
                u32x4 o; o.x = pk2(a[0], a[1]); o.y = pk2(a[2], a[3]); o.z = pk2(a[4], a[5]); o.w = pk2(a[6], a[7]);
                *(u32x4*)(dst + (size_t)(m0 + t + q) * 1024) = o;
#pragma unroll
                for (int j = 0; j < 8; ++j) { xw[0][j] = xw[1][j]; xw[1][j] = xw[2][j]; xw[2][j] = xc[j]; }
            }
        }
    }
    const int sub = lane >> 4, l16 = lane & 15;
    for (int it = gw; it < M / 4; it += ngw) {
        const int m = it * 4 + sub;
        const bf16_t* row = PA + (size_t)m * NA;
        if (l16 < 8) { const float br = AB[(size_t)m * 16 + l16], ar = AB[(size_t)m * 16 + 8 + l16];
            BETA[(size_t)m * 8 + l16] = sigm(br);
            const float xx = ar + P.dt_bias[l16]; const float sp = fmaxf(xx, 0.f) + log1pf(__expf(-fabsf(xx)));
            GG[(size_t)m * 8 + l16] = -__expf(P.a_log[l16]) * sp; }
        {
            float v[3][8]; float ss = 0.f;
#pragma unroll
            for (int j = 0; j < 3; ++j) { unpack8(v[j], *(const u32x4*)(row + 3088 + 8 * (l16 + 16 * j)));
#pragma unroll
                for (int e = 0; e < 8; ++e) ss += v[j][e] * v[j][e]; }
            const float r = rsqrtf(sum16(ss) * (1.f / 384.f) + 1e-6f);
#pragma unroll
            for (int j = 0; j < 3; ++j) { const int idx = 8 * (l16 + 16 * j); const f32x4 wa = *(const f32x4*)(P.q_norm_w + idx), wb = *(const f32x4*)(P.q_norm_w + idx + 4);
                u32x4 o; o.x = pk2(v[j][0] * r * wa[0], v[j][1] * r * wa[1]); o.y = pk2(v[j][2] * r * wa[2], v[j][3] * r * wa[3]); o.z = pk2(v[j][4] * r * wb[0], v[j][5] * r * wb[1]); o.w = pk2(v[j][6] * r * wb[2], v[j][7] * r * wb[3]);
                *(u32x4*)(CQ + (size_t)m * 384 + idx) = o; }
        }
        {
            float v[2][8]; float ss = 0.f;
#pragma unroll
            for (int j = 0; j < 2; ++j) { unpack8(v[j], *(const u32x4*)(row + 3472 + 8 * (l16 + 16 * j)));
#pragma unroll
                for (int e = 0; e < 8; ++e) ss += v[j][e] * v[j][e]; }
            const float r = rsqrtf(sum16(ss) * (1.f / 256.f) + 1e-6f);
#pragma unroll
            for (int j = 0; j < 2; ++j) { const int idx = 8 * (l16 + 16 * j); const f32x4 wa = *(const f32x4*)(P.kv_norm_w + idx), wb = *(const f32x4*)(P.kv_norm_w + idx + 4);
                u32x4 o; o.x = pk2(v[j][0] * r * wa[0], v[j][1] * r * wa[1]); o.y = pk2(v[j][2] * r * wa[2], v[j][3] * r * wa[3]); o.z = pk2(v[j][4] * r * wb[0], v[j][5] * r * wb[1]); o.w = pk2(v[j][6] * r * wb[2], v[j][7] * r * wb[3]);
                *(u32x4*)(CKV + (size_t)m * 256 + idx) = o; }
        }
        {
            const unsigned ua = *(const unsigned*)(row + 3728 + 2 * l16), ub = *(const unsigned*)(row + 3728 + 32 + 2 * l16);
            const int ps = P.pos[m]; float c0_, s0_, c1_, s1_; rope_cs(ps, 2 * l16, c0_, s0_); rope_cs(ps, 2 * l16 + 1, c1_, s1_);
            const float a1 = bflo(ua), a2 = bflo(ub), b1 = bfhi(ua), b2 = bfhi(ub);
            u32x2 o; o.x = pk2(a1 * c0_ - a2 * s0_, a2 * c0_ + a1 * s0_); o.y = pk2(b1 * c1_ - b2 * s1_, b2 * c1_ + b1 * s1_);
            *(u32x2*)(KR + (size_t)m * 64 + 4 * l16) = o;
        }
    }
}

typedef float f32x16 __attribute__((ext_vector_type(16)));
typedef short s16x4 __attribute__((ext_vector_type(4)));
#define LAS __attribute__((address_space(3)))
typedef LAS unsigned char* lptr;
DI s16x4 vtr(lptr p) { return __builtin_bit_cast(s16x4, __builtin_amdgcn_ds_read_tr16_b64_v4i16((LAS s16x4*)p)); }
#define MFMA32(a, b, c) __builtin_amdgcn_mfma_f32_32x32x16_bf16((a), (b), (c), 0, 0, 0)
DI bf16x8 pack8(const f32x16& x, int o) { u32x4 p; p.x = pk2(x[o], x[o + 1]); p.y = pk2(x[o + 2], x[o + 3]); p.z = pk2(x[o + 4], x[o + 5]); p.w = pk2(x[o + 6], x[o + 7]); return __builtin_bit_cast(bf16x8, p); }
DI void attn_unit(const Params& P, unsigned char* lds_, int bh, int qb) {
    lptr lds = (lptr)lds_;
    constexpr int KP = 400, VP = 272, KBUF = 64 * KP, VBUF = 64 * VP;
    unsigned char* ws = P.ws;
    bf16_t* Qg = (bf16_t*)(ws + O_Q); const bf16_t* KN = (const bf16_t*)(ws + O_KN); const bf16_t* V = (const bf16_t*)(ws + O_V); const bf16_t* KR = (const bf16_t*)(ws + O_KR);
    const int tid = threadIdx.x, lane = tid & 63, w = __builtin_amdgcn_readfirstlane(tid >> 6), r32 = lane & 31, hi = lane >> 5;
    const int b = bh >> 3, h = bh & 7;
    const size_t rowb = (size_t)b * S;
    {
        {
            const int q0 = qb * 256, NT = (q0 + 256) / 64;
            const int qrow = q0 + 32 * w + r32;
            bf16x8 qf[12];
            { const bf16_t* qp = Qg + (rowb + qrow) * 1536 + h * 192 + 8 * hi;
#pragma unroll
              for (int ks = 0; ks < 12; ++ks) qf[ks] = *(const bf16x8*)(qp + 16 * ks);
              const int ps = P.pos[rowb + qrow];
#pragma unroll
              for (int ks = 8; ks < 12; ++ks) { u32x4 u = __builtin_bit_cast(u32x4, qf[ks]);
#pragma unroll
                  for (int pj = 0; pj < 4; ++pj) { float c, s; rope_cs(ps, 8 * (ks - 8) + 4 * hi + pj, c, s); const unsigned w = u[pj]; const float t1 = bflo(w), t2 = bfhi(w); u[pj] = pk2(t1 * c - t2 * s, t2 * c + t1 * s); }
                  qf[ks] = __builtin_bit_cast(bf16x8, u); } }
            const bf16_t* kn_src = KN + (rowb + (tid >> 4)) * 1024 + h * 128 + (tid & 15) * 8;
            const bf16_t* kr_src = KR + (rowb + (tid >> 3)) * 64 + (tid & 7) * 8;
            const bf16_t* v_src = V + (rowb + (tid >> 4)) * 1024 + h * 128 + (tid & 15) * 8;
            const int kdst = (tid >> 4) * KP + (tid & 15) * 16, krdst = (tid >> 3) * KP + 256 + (tid & 7) * 16, vdst = (tid >> 4) * VP + (tid & 15) * 16;
            u32x4 st0, st1, st2, st3, st4_;
#define LOADT(kt) do { const size_t o_ = (size_t)(kt) * 64; st0 = *(const u32x4*)(kn_src + o_ * 1024); st1 = *(const u32x4*)(kn_src + (o_ + 32) * 1024); st2 = *(const u32x4*)(kr_src + o_ * 64); \
                       st3 = *(const u32x4*)(v_src + o_ * 1024); st4_ = *(const u32x4*)(v_src + (o_ + 32) * 1024); } while (0)
#define STORET(buf) do { lptr kb_ = lds + (buf) * KBUF; lptr vb_ = lds + 2 * KBUF + (buf) * VBUF; *(LAS u32x4*)(kb_ + kdst) = st0; *(LAS u32x4*)(kb_ + kdst + 32 * KP) = st1; *(LAS u32x4*)(kb_ + krdst) = st2; \
                         *(LAS u32x4*)(vb_ + vdst) = st3; *(LAS u32x4*)(vb_ + vdst + 32 * VP) = st4_; } while (0)
            __syncthreads();
            LOADT(0); STORET(0);
            __syncthreads();
            f32x16 o[4];
#pragma unroll
            for (int d = 0; d < 4; ++d)
#pragma unroll
                for (int i = 0; i < 16; ++i) o[d][i] = 0.f;
            float m_run = -1e30f, l_run = 0.f;
            for (int kt = 0; kt < NT; ++kt) {
                const int buf = kt & 1;
                if (kt + 1 < NT) LOADT(kt + 1);
                if (64 * kt <= q0 + 32 * w + 31) {
                    lptr kb = lds + buf * KBUF + r32 * KP + hi * 16;
                    f32x16 s0, s1;
#pragma unroll
                    for (int i = 0; i < 16; ++i) { s0[i] = 0.f; s1[i] = 0.f; }
#pragma unroll
                    for (int ks = 0; ks < 12; ++ks) { const bf16x8 a0 = *(const LAS bf16x8*)(kb + ks * 32), a1 = *(const LAS bf16x8*)(kb + 32 * KP + ks * 32);
                        s0 = MFMA32(a0, qf[ks], s0); s1 = MFMA32(a1, qf[ks], s1); }
                    if (64 * kt + 63 > q0 + 32 * w) {
                        const int kv0 = 64 * kt + 4 * hi;
#pragma unroll
                        for (int i = 0; i < 16; ++i) { const int kv = kv0 + (i & 3) + 8 * (i >> 2); if (kv > qrow) s0[i] = -1e30f; if (kv + 32 > qrow) s1[i] = -1e30f; }
                    }
                    float mx = fmaxf(s0[0], s1[0]);
#pragma unroll
                    for (int i = 1; i < 16; ++i) mx = fmaxf(mx, fmaxf(s0[i], s1[i]));
                    mx = fmaxf(mx, __shfl_xor(mx, 32));
                    const float m_new = fmaxf(m_run, mx);
                    if (__builtin_amdgcn_ballot_w64(m_new > m_run) != 0ull) {
                        const float al = __builtin_amdgcn_exp2f(m_run - m_new); l_run *= al;
#pragma unroll
                        for (int d = 0; d < 4; ++d) o[d] = o[d] * al;
                    }
                    m_run = m_new;
                    float ps = 0.f;
#pragma unroll
                    for (int i = 0; i < 16; ++i) { s0[i] = __builtin_amdgcn_exp2f(s0[i] - m_new); s1[i] = __builtin_amdgcn_exp2f(s1[i] - m_new); ps += s0[i] + s1[i]; }
                    l_run += ps;
                    bf16x8 pf[4]; pf[0] = pack8(s0, 0); pf[1] = pack8(s0, 8); pf[2] = pack8(s1, 0); pf[3] = pack8(s1, 8);
                    __builtin_amdgcn_sched_barrier(0);
                    lptr vb = lds + 2 * KBUF + buf * VBUF + (4 * hi + ((lane & 15) >> 2)) * VP + (((lane >> 4) & 1) * 16 + (lane & 3) * 4) * 2;
#pragma unroll
                    for (int s = 0; s < 4; ++s)
#pragma unroll
                        for (int d = 0; d < 4; ++d) { const s16x4 lo = vtr(vb + s * 16 * VP + d * 64), hh = vtr(vb + (s * 16 + 8) * VP + d * 64);
                            const bf16x8 a = __builtin_shufflevector(lo, hh, 0, 1, 2, 3, 4, 5, 6, 7); o[d] = MFMA32(a, pf[s], o[d]); }
                }
                if (kt + 1 < NT) STORET(buf ^ 1);
                __syncthreads();
            }
#undef LOADT
#undef STORET
            l_run += __shfl_xor(l_run, 32);
            const float il = 1.f / l_run;
            bf16_t* op = Qg + (rowb + qrow) * 1536 + h * 192 + 4 * hi;
#pragma unroll
            for (int d = 0; d < 4; ++d)
#pragma unroll
                for (int g = 0; g < 4; ++g) st4(op + 32 * d + 8 * g, (f32x4){o[d][4 * g], o[d][4 * g + 1], o[d][4 * g + 2], o[d][4 * g + 3]} * il);
        }
    }
}

DI void attn_queue(const Params& P, unsigned char* lds_, unsigned* qcnt) {
    LAS int* slot = (LAS int*)((lptr)lds_ + 147392);
    const int myx = blockIdx.x & 7;
    for (int qq = 0; qq < 8; ++qq) {
        const int x = (myx + qq) & 7;
        for (;;) {
            __syncthreads();
            if (threadIdx.x == 0) *slot = (int)__hip_atomic_fetch_add(qcnt + 64 * x, 1u, __ATOMIC_RELAXED, __HIP_MEMORY_SCOPE_AGENT);
            __syncthreads();
            const int k = *slot;
            if (k >= 64) break;
            attn_unit(P, lds_, 4 * x + (k & 3), 15 - (k >> 2));
        }
    }
}

#define LFENCE() asm volatile("s_waitcnt lgkmcnt(0)" ::: "memory")
DI int crow(int r, int hi) { return (r & 3) + 8 * (r >> 2) + 4 * hi; }
DI unsigned char* rawp(unsigned char* basep, size_t m0, int h, int o) { return basep + (m0 + (size_t)(o >> 8)) * 2048 + h * 256 + (o & 255); }
DI void store_raw(unsigned char* p, const f32x16& x) { *(u32x4*)p = __builtin_bit_cast(u32x4, pack8(x, 0)); *(u32x4*)(p + 16) = __builtin_bit_cast(u32x4, pack8(x, 8)); }
DI void delta_A(const Params& P, unsigned char* lds_, int gw, int ngw, int lane, int wid) {
    unsigned char* ws = P.ws;
    lptr base = (lptr)lds_ + wid * 18432;
    LAS float* Lm = (LAS float*)base;
    LAS float* gc = (LAS float*)(base + 17408); LAS float* bu = gc + 64; LAS float* bw = bu + 64; LAS float* tl = bw + 64;
    bf16_t* DQ = (bf16_t*)P.out; const bf16_t* DK = DQ + (size_t)M * 1024; const bf16_t* DV = (const bf16_t*)(ws + O_DV);
    const float* BETA = (const float*)(ws + O_BETA); const float* GG = (const float*)(ws + O_GG); float* EGL = (float*)(ws + O_EGL);
    for (int ch = gw; ch < 2048; ch += ngw) {
        asm volatile("" : "+v"(lane));
        const int r32 = lane & 31, hi = lane >> 5;
        const int h = ch & 7, bn = ch >> 3, b = bn >> 6, n = bn & 63; const size_t m0 = (size_t)b * S + 64 * n;
        LFENCE();
        {
            float g = GG[(m0 + lane) * 8 + h]; const float be = BETA[(m0 + lane) * 8 + h];
#pragma unroll
            for (int o = 1; o < 64; o <<= 1) { const float t = __shfl_up(g, o); if (lane >= o) g += t; }
            const float gl = __shfl(g, 63);
            gc[lane] = g; bu[lane] = be; bw[lane] = -be * __expf(g); tl[lane] = __expf(gl - g);
            if (lane == 0) EGL[ch] = __expf(gl);
        }
        LFENCE();
        {
#pragma unroll
            for (int t = 0; t < 3; ++t) { const int ib = t == 0 ? 0 : 1, jb = t == 2 ? 1 : 0;
                f32x16 x;
#pragma unroll
                for (int i = 0; i < 16; ++i) x[i] = 0.f;
#pragma unroll
                for (int ks = 0; ks < 8; ++ks) { const bf16x8 ka = *(const bf16x8*)(DK + (m0 + 32 * ib + r32) * 1024 + h * 128 + 16 * ks + 8 * hi), kb = *(const bf16x8*)(DK + (m0 + 32 * jb + r32) * 1024 + h * 128 + 16 * ks + 8 * hi);
                    x = MFMA32(ka, kb, x); }
                const int j = 32 * jb + r32; const float gcj = gc[j];
#pragma unroll
                for (int r = 0; r < 16; ++r) { const int i = 32 * ib + crow(r, hi); Lm[i * 68 + j] = (j < i) ? bu[i] * x[r] * __expf(gc[i] - gcj) : 0.f; }
            }
#pragma unroll
            for (int r = 0; r < 16; ++r) Lm[crow(r, hi) * 68 + 32 + r32] = 0.f;
#pragma unroll
            for (int t = 0; t < 3; ++t) { const int jb = t == 2 ? 1 : 0, ib = t == 0 ? 0 : 1;
                f32x16 x;
#pragma unroll
                for (int q = 0; q < 16; ++q) x[q] = 0.f;
#pragma unroll
                for (int ks = 0; ks < 8; ++ks) { const bf16x8 ka = *(const bf16x8*)(DK + (m0 + 32 * jb + r32) * 1024 + h * 128 + 16 * ks + 8 * hi), qb = *(const bf16x8*)(DQ + (m0 + 32 * ib + r32) * 1024 + h * 128 + 16 * ks + 8 * hi);
                    x = MFMA32(ka, qb, x); }
                const int i = 32 * ib + r32; const float gci = gc[i];
#pragma unroll
                for (int r = 0; r < 16; ++r) { const int j = 32 * jb + crow(r, hi); x[r] = (j <= i) ? x[r] * __expf(gci - gc[j]) : 0.f; }
                store_raw(ws + O_INTRA + (size_t)ch * 6144 + t * 2048 + lane * 32, x);
            }
        }
        LFENCE();
        {
            float t[64];
            t[0] = (lane == 0) ? 1.f : 0.f;
#pragma unroll
            for (int i = 1; i < 64; ++i) {
                float a0 = 0.f, a1 = 0.f, a2 = 0.f, a3 = 0.f;
#pragma unroll
                for (int j = 0; j < i; j += 4) { const f32x4 l4 = *(const LAS f32x4*)(Lm + i * 68 + j);
                    a0 += l4[0] * t[j]; if (j + 1 < i) a1 += l4[1] * t[j + 1]; if (j + 2 < i) a2 += l4[2] * t[j + 2]; if (j + 3 < i) a3 += l4[3] * t[j + 3]; }
                t[i] = ((lane == i) ? 1.f : 0.f) - ((a0 + a1) + (a2 + a3));
            }
            LFENCE();
#pragma unroll
            for (int i = 0; i < 64; ++i) Lm[i * 68 + lane] = t[i];
        }
        LFENCE();
        bf16x8 Tu[6], Tw[6];
#pragma unroll
        for (int q = 0; q < 6; ++q) { const int ib = q < 2 ? 0 : 1, s = q < 2 ? q : q - 2; const int i = 32 * ib + r32;
            const LAS float* tp = Lm + i * 68 + 16 * s + 8 * hi; const f32x4 t0 = *(const LAS f32x4*)tp, t1 = *(const LAS f32x4*)(tp + 4);
            const f32x4 u0 = *(const LAS f32x4*)(bu + 16 * s + 8 * hi), u1 = *(const LAS f32x4*)(bu + 16 * s + 8 * hi + 4);
            const f32x4 w0 = *(const LAS f32x4*)(bw + 16 * s + 8 * hi), w1 = *(const LAS f32x4*)(bw + 16 * s + 8 * hi + 4);
            const f32x4 a0 = t0 * u0, a1 = t1 * u1, c0 = t0 * w0, c1 = t1 * w1;
            u32x4 pu, pw; pu.x = pk2(a0[0], a0[1]); pu.y = pk2(a0[2], a0[3]); pu.z = pk2(a1[0], a1[1]); pu.w = pk2(a1[2], a1[3]);
            pw.x = pk2(c0[0], c0[1]); pw.y = pk2(c0[2], c0[3]); pw.z = pk2(c1[0], c1[1]); pw.w = pk2(c1[2], c1[3]);
            Tu[q] = __builtin_bit_cast(bf16x8, pu); Tw[q] = __builtin_bit_cast(bf16x8, pw); }
        const float tli = tl[r32], tli1 = tl[32 + r32], eg0 = __expf(gc[r32]), eg1 = __expf(gc[32 + r32]);
        LFENCE();
#pragma unroll 8
        for (int it = 0; it < 16; ++it) { const int idx = it * 64 + lane, row = idx >> 4, c16 = idx & 15;
            *(LAS u32x4*)(base + row * 272 + c16 * 16) = *(const u32x4*)(DV + (m0 + row) * 1024 + h * 128 + c16 * 8); }
        LFENCE();
        lptr vb = base + (8 * hi + ((lane & 15) >> 2)) * 272 + (((lane >> 4) & 1) * 16 + (lane & 3) * 4) * 2;
#pragma unroll 1
        for (int eb = 0; eb < 4; ++eb) {
            bf16x8 vf[4];
#pragma unroll
            for (int s = 0; s < 4; ++s) { const s16x4 lo = vtr(vb + 16 * s * 272 + eb * 64), hh = vtr(vb + (16 * s + 4) * 272 + eb * 64); vf[s] = __builtin_shufflevector(lo, hh, 0, 1, 2, 3, 4, 5, 6, 7); }
#pragma unroll
            for (int ib = 0; ib < 2; ++ib) { f32x16 x;
#pragma unroll
                for (int i = 0; i < 16; ++i) x[i] = 0.f;
#pragma unroll
                for (int s = 0; s < 4; ++s) if (ib == 1 || s < 2) x = MFMA32(Tu[ib == 0 ? s : 2 + s], vf[s], x);
                store_raw(rawp(ws + O_DV, m0, h, (eb * 2 + ib) * 2048 + lane * 32), x); }
        }
        LFENCE();
#pragma unroll 8
        for (int it = 0; it < 16; ++it) { const int idx = it * 64 + lane, row = idx >> 4, c16 = idx & 15;
            *(LAS u32x4*)(base + row * 272 + c16 * 16) = *(const u32x4*)(DK + (m0 + row) * 1024 + h * 128 + c16 * 8); }
        LFENCE();
#pragma unroll 1
        for (int dkb = 0; dkb < 4; ++dkb) {
            bf16x8 kf[4];
#pragma unroll
            for (int s = 0; s < 4; ++s) { const s16x4 lo = vtr(vb + 16 * s * 272 + dkb * 64), hh = vtr(vb + (16 * s + 4) * 272 + dkb * 64); kf[s] = __builtin_shufflevector(lo, hh, 0, 1, 2, 3, 4, 5, 6, 7); }
#pragma unroll
            for (int ib = 0; ib < 2; ++ib) { f32x16 x;
#pragma unroll
                for (int i = 0; i < 16; ++i) x[i] = 0.f;
#pragma unroll
                for (int s = 0; s < 4; ++s) if (ib == 1 || s < 2) x = MFMA32(kf[s], Tw[ib == 0 ? s : 2 + s], x);
                store_raw(ws + O_WT + (size_t)ch * 16384 + (dkb * 2 + ib) * 2048 + lane * 32, x); }
#pragma unroll
            for (int ib = 0; ib < 2; ++ib) { f32x16 x;
#pragma unroll
                for (int i = 0; i < 16; ++i) x[i] = 0.f;
                const unsigned tb = f2bf(ib ? tli1 : tli);
#pragma unroll
                for (int t = 0; t < 2; ++t) { const int rel = r32 - 16 * t - 8 * hi;
                    u32x4 d; d.x = (rel == 0 ? tb : 0u) | (rel == 1 ? tb << 16 : 0u); d.y = (rel == 2 ? tb : 0u) | (rel == 3 ? tb << 16 : 0u);
                    d.z = (rel == 4 ? tb : 0u) | (rel == 5 ? tb << 16 : 0u); d.w = (rel == 6 ? tb : 0u) | (rel == 7 ? tb << 16 : 0u);
                    x = MFMA32(__builtin_bit_cast(bf16x8, d), kf[2 * ib + t], x); }
                store_raw(rawp((unsigned char*)DQ + (size_t)M * 2048, m0, h, (ib * 4 + dkb) * 2048 + lane * 32), x); }
        }
        LFENCE();
#pragma unroll 8
        for (int it = 0; it < 16; ++it) { const int idx = it * 64 + lane, row = idx >> 4, c16 = idx & 15;
            *(LAS u32x4*)(base + row * 272 + c16 * 16) = *(const u32x4*)(DQ + (m0 + row) * 1024 + h * 128 + c16 * 8); }
        asm volatile("s_waitcnt vmcnt(0) lgkmcnt(0)" ::: "memory");
#pragma unroll
        for (int blk = 0; blk < 8; ++blk) { const int dkb = blk >> 1, ib = blk & 1; const float e = ib ? eg1 : eg0;
            lptr qp = base + (32 * ib + r32) * 272 + (32 * dkb + 4 * hi) * 2;
            u32x2 q0 = *(const LAS u32x2*)qp, q1 = *(const LAS u32x2*)(qp + 16), q2 = *(const LAS u32x2*)(qp + 32), q3 = *(const LAS u32x2*)(qp + 48);
            u32x4 lo, hh;
            lo.x = pk2(bflo(q0.x) * e, bfhi(q0.x) * e); lo.y = pk2(bflo(q0.y) * e, bfhi(q0.y) * e); lo.z = pk2(bflo(q1.x) * e, bfhi(q1.x) * e); lo.w = pk2(bflo(q1.y) * e, bfhi(q1.y) * e);
            hh.x = pk2(bflo(q2.x) * e, bfhi(q2.x) * e); hh.y = pk2(bflo(q2.y) * e, bfhi(q2.y) * e); hh.z = pk2(bflo(q3.x) * e, bfhi(q3.x) * e); hh.w = pk2(bflo(q3.y) * e, bfhi(q3.y) * e);
            const int o = blk * 2048 + lane * 32;
            unsigned char* dst = (unsigned char*)DQ + (m0 + (o >> 8)) * 2048 + h * 256 + (o & 255);
            *(u32x4*)dst = lo; *(u32x4*)(dst + 16) = hh; }
    }
}
DI void unpack16(f32x16& x, const unsigned char* p) { const u32x4 a = *(const u32x4*)p, b = *(const u32x4*)(p + 16);
    x[0] = bflo(a.x); x[1] = bfhi(a.x); x[2] = bflo(a.y); x[3] = bfhi(a.y); x[4] = bflo(a.z); x[5] = bfhi(a.z); x[6] = bflo(a.w); x[7] = bfhi(a.w);
    x[8] = bflo(b.x); x[9] = bfhi(b.x); x[10] = bflo(b.y); x[11] = bfhi(b.y); x[12] = bflo(b.z); x[13] = bfhi(b.z); x[14] = bflo(b.w); x[15] = bfhi(b.w); }
#define RAWBAR() do { asm volatile("s_waitcnt lgkmcnt(0)" ::: "memory"); __builtin_amdgcn_s_barrier(); asm volatile("" ::: "memory"); } while (0)
DI void delta_B2(const Params& P, unsigned char* lds_, int bh) {
    lptr lds = (lptr)lds_;
    constexpr int BUF = 55296;
    unsigned char* ws = P.ws;
    const int tid = threadIdx.x, lane = tid & 63, wid = __builtin_amdgcn_readfirstlane(tid >> 6);
    const int b = bh >> 3, h = bh & 7;
    unsigned char* dq = (unsigned char*)P.out; unsigned char* dk = dq + (size_t)M * 2048; unsigned char* dv = ws + O_DV;
    __syncthreads();
    if (wid >= 4) {
        const int tl = tid - 256;
        u32x4 ra[14], rb[14];
#define DB_LD(n, r) do { const int ch_ = (b * 64 + (n)) * 8 + h; const size_t m0_ = (size_t)b * S + 64 * (n); \
        _Pragma("unroll") for (int j = 0; j < 14; ++j) { const int idx = tl + 256 * j; if (j < 13 || tl < 128) { const unsigned char* s_; \
            if (j < 4) s_ = ws + O_WT + (size_t)ch_ * 16384 + idx * 16; \
            else if (j < 8) s_ = rawp(dq, m0_, h, (idx - 1024) * 16); \
            else if (j < 12) s_ = rawp(dk, m0_, h, (idx - 2048) * 16); \
            else s_ = ws + O_INTRA + (size_t)ch_ * 6144 + (idx - 3072) * 16; \
            r[j] = *(const u32x4*)s_; } } } while (0)
#define DB_ST(bufi, r) do { _Pragma("unroll") for (int j = 0; j < 14; ++j) { const int idx = tl + 256 * j; if (j < 13 || tl < 128) *(LAS u32x4*)(lds + (bufi) * BUF + idx * 16) = r[j]; } } while (0)
        DB_LD(0, ra); DB_LD(1, rb); DB_ST(0, ra); DB_LD(2, ra);
        __syncthreads();
        for (int n = 0; n < 64; n += 2) {
            DB_ST(1, rb); if (n + 3 < 64) DB_LD(n + 3, rb);
            RAWBAR();
            if (n + 2 < 64) { DB_ST(0, ra); if (n + 4 < 64) DB_LD(n + 4, ra); }
            RAWBAR();
        }
#undef DB_LD
#undef DB_ST
    } else {
        const int eb = wid;
        const float* EGL = (const float*)(ws + O_EGL);
        f32x16 St[4];
#pragma unroll
        for (int d = 0; d < 4; ++d)
#pragma unroll
            for (int i = 0; i < 16; ++i) St[d][i] = 0.f;
        u32x4 up[4];
        { unsigned char* u0 = rawp(dv, (size_t)b * S, h, (eb * 2) * 2048 + lane * 32), *u1 = rawp(dv, (size_t)b * S, h, (eb * 2 + 1) * 2048 + lane * 32);
          up[0] = *(const u32x4*)u0; up[1] = *(const u32x4*)(u0 + 16); up[2] = *(const u32x4*)u1; up[3] = *(const u32x4*)(u1 + 16); }
        __syncthreads();
        for (int n = 0; n < 64; ++n) {
            const int ch = (b * 64 + n) * 8 + h; const size_t m0 = (size_t)b * S + 64 * n;
            lptr bf = lds + (n & 1) * BUF + lane * 32;
            const float eg = EGL[ch];
            f32x16 vn[2], ob[2];
#pragma unroll
            for (int ib = 0; ib < 2; ++ib) { const u32x4 a = up[2 * ib], c = up[2 * ib + 1];
                vn[ib][0] = bflo(a.x); vn[ib][1] = bfhi(a.x); vn[ib][2] = bflo(a.y); vn[ib][3] = bfhi(a.y); vn[ib][4] = bflo(a.z); vn[ib][5] = bfhi(a.z); vn[ib][6] = bflo(a.w); vn[ib][7] = bfhi(a.w);
                vn[ib][8] = bflo(c.x); vn[ib][9] = bfhi(c.x); vn[ib][10] = bflo(c.y); vn[ib][11] = bfhi(c.y); vn[ib][12] = bflo(c.z); vn[ib][13] = bfhi(c.z); vn[ib][14] = bflo(c.w); vn[ib][15] = bfhi(c.w); }
            unsigned char* o0 = rawp(dv, m0, h, (eb * 2) * 2048 + lane * 32); unsigned char* o1 = rawp(dv, m0, h, (eb * 2 + 1) * 2048 + lane * 32);
            if (n + 1 < 64) { const unsigned char* u0 = rawp(dv, m0 + 64, h, (eb * 2) * 2048 + lane * 32); const unsigned char* u1 = rawp(dv, m0 + 64, h, (eb * 2 + 1) * 2048 + lane * 32);
                up[0] = *(const u32x4*)u0; up[1] = *(const u32x4*)(u0 + 16); up[2] = *(const u32x4*)u1; up[3] = *(const u32x4*)(u1 + 16); }
            bf16x8 Spk[8];
#pragma unroll
            for (int s = 0; s < 8; ++s) Spk[s] = pack8(St[s >> 1], 8 * (s & 1));
#pragma unroll
            for (int i = 0; i < 16; ++i) { ob[0][i] = 0.f; ob[1][i] = 0.f; }
#pragma unroll
            for (int s = 0; s < 8; ++s)
#pragma unroll
                for (int ib = 0; ib < 2; ++ib) { const int o = ((s >> 1) * 2 + ib) * 2048 + 16 * (s & 1);
                    vn[ib] = MFMA32(*(const LAS bf16x8*)(bf + o), Spk[s], vn[ib]);
                    ob[ib] = MFMA32(*(const LAS bf16x8*)(bf + 16384 + o), Spk[s], ob[ib]); }
            bf16x8 vpk[2][2];
#pragma unroll
            for (int ib = 0; ib < 2; ++ib) { vpk[ib][0] = pack8(vn[ib], 0); vpk[ib][1] = pack8(vn[ib], 8); }
#pragma unroll
            for (int t = 0; t < 2; ++t) {
                ob[0] = MFMA32(*(const LAS bf16x8*)(bf + 49152 + 0 * 2048 + 16 * t), vpk[0][t], ob[0]);
                ob[1] = MFMA32(*(const LAS bf16x8*)(bf + 49152 + 1 * 2048 + 16 * t), vpk[0][t], ob[1]);
                ob[1] = MFMA32(*(const LAS bf16x8*)(bf + 49152 + 2 * 2048 + 16 * t), vpk[1][t], ob[1]);
            }
            store_raw(o0, ob[0]); store_raw(o1, ob[1]);
#pragma unroll
            for (int dkb = 0; dkb < 4; ++dkb) { St[dkb] = St[dkb] * eg;
#pragma unroll
                for (int s = 0; s < 4; ++s) St[dkb] = MFMA32(*(const LAS bf16x8*)(bf + 32768 + ((s >> 1) * 4 + dkb) * 2048 + 16 * (s & 1)), vpk[s >> 1][s & 1], St[dkb]); }
            RAWBAR();
        }
    }
    __syncthreads();
}

DI void p9_normgate(const Params& P, unsigned char* lds_, int gw, int ngw, int lane, int wid) {
    unsigned char* ws = P.ws;
    lptr tile = (lptr)lds_ + wid * 18432;
    const bf16_t* Z = (const bf16_t*)(ws + O_Z); bf16_t* OG = (bf16_t*)P.out + (size_t)M * 1024;
    const int r32 = lane & 31, hi = lane >> 5;
    for (int ch = gw; ch < 2048; ch += ngw) {
        const int h = ch & 7, bn = ch >> 3, b = bn >> 6, n = bn & 63; const size_t m0 = (size_t)b * S + 64 * n;
        LFENCE();
#pragma unroll 1
        for (int ib = 0; ib < 2; ++ib) {
            f32x16 o[4]; float ss[16];
#pragma unroll
            for (int eb = 0; eb < 4; ++eb) unpack16(o[eb], rawp(ws + O_DV, m0, h, (eb * 2 + ib) * 2048 + lane * 32));
#pragma unroll
            for (int r = 0; r < 16; ++r) { float s = o[0][r] * o[0][r] + o[1][r] * o[1][r] + o[2][r] * o[2][r] + o[3][r] * o[3][r];
                s += __shfl_xor(s, 1); s += __shfl_xor(s, 2); s += __shfl_xor(s, 4); s += __shfl_xor(s, 8); s += __shfl_xor(s, 16);
                ss[r] = rsqrtf(s * (1.f / 128.f) + 1e-6f); }
#pragma unroll
            for (int eb = 0; eb < 4; ++eb) { const float w = P.dn_norm_w[32 * eb + r32];
                lptr tp = tile + (32 * ib + 4 * hi) * 272 + (32 * eb + r32) * 2;
#pragma unroll
                for (int r = 0; r < 16; ++r) *(LAS bf16_t*)(tp + ((r & 3) + 8 * (r >> 2)) * 272) = (bf16_t)f2bf(o[eb][r] * ss[r] * w); }
        }
        LFENCE();
#pragma unroll 4
        for (int it = 0; it < 16; ++it) { const int idx = it * 64 + lane, row = idx >> 4, c16 = idx & 15;
            const size_t off = (m0 + row) * 1024 + h * 128 + c16 * 8;
            const u32x4 v = *(const LAS u32x4*)(tile + row * 272 + c16 * 16), z = *(const u32x4*)(Z + off);
            u32x4 o; o.x = pk2(bflo(v.x) * silu(bflo(z.x)), bfhi(v.x) * silu(bfhi(z.x))); o.y = pk2(bflo(v.y) * silu(bflo(z.y)), bfhi(v.y) * silu(bfhi(z.y)));
            o.z = pk2(bflo(v.z) * silu(bflo(z.z)), bfhi(v.z) * silu(bfhi(z.z))); o.w = pk2(bflo(v.w) * silu(bflo(z.w)), bfhi(v.w) * silu(bfhi(z.w)));
            *(u32x4*)(OG + off) = o; }
    }
}
DI void ln_rows(const float* __restrict__ in, float* __restrict__ outf, bf16_t* __restrict__ outb, const float* g, const float* bta, int gw, int ngw, int lane) {
    for (int m = gw; m < M; m += ngw) {
        const f32x4* xr = (const f32x4*)(in + (size_t)m * D) + lane;
        f32x4 v[4]; float s = 0.f;
#pragma unroll
        for (int j = 0; j < 4; ++j) { v[j] = xr[64 * j]; s += (v[j][0] + v[j][1]) + (v[j][2] + v[j][3]); }
        const float mean = wave_sum(s) * (1.f / D); float s2 = 0.f;
#pragma unroll
        for (int j = 0; j < 4; ++j) { v[j] = v[j] - mean; s2 += (v[j][0] * v[j][0] + v[j][1] * v[j][1]) + (v[j][2] * v[j][2] + v[j][3] * v[j][3]); }
        const float rstd = rsqrtf(wave_sum(s2) * (1.f / D) + 1e-5f);
#pragma unroll
        for (int j = 0; j < 4; ++j) { const int c = 4 * lane + 256 * j; const f32x4 gg = *(const f32x4*)(g + c), bb = *(const f32x4*)(bta + c); const f32x4 o = v[j] * rstd * gg + bb;
            *(f32x4*)(outf + (size_t)m * D + c) = o; if (outb) st4(outb + (size_t)m * D + c, o); }
    }
}

#define XB_TMO      128
#define XB_XCNT(j)  (256  + 64 * (j))
#define XB_XSUB(j)  (1280 + 64 * (j))
#define XB_XGEN(j)  (2304 + 64 * (j))
#define XB_TOP      3328
#define XB_TOPGEN   3392
#define XCD_BAR_WORDS 3456
#define XB_SPIN_CAP (1u << 22)
DI unsigned xb_ld(unsigned* p)              { return __hip_atomic_load(p, __ATOMIC_RELAXED, __HIP_MEMORY_SCOPE_AGENT); }
DI unsigned xb_add(unsigned* p, unsigned v) { return __hip_atomic_fetch_add(p, v, __ATOMIC_RELAXED, __HIP_MEMORY_SCOPE_AGENT); }
DI unsigned xb_xcc_id() { return (unsigned)__builtin_amdgcn_s_getreg((3 << 11) | 20) & 0xFu; }
#define XB_SPIN(cond, bar) do { unsigned _sp = 0; while (cond) { __builtin_amdgcn_s_sleep(1); \
    if ((++_sp & 255u) == 0u) { if (xb_ld(&(bar)[XB_TMO])) break; if (_sp > XB_SPIN_CAP) { atomicAdd(&(bar)[XB_TMO], 1u); break; } } } } while (0)
struct XcdBarrier { unsigned* bar; unsigned x; volatile LAS unsigned* st; };
DI XcdBarrier xcd_barrier_post(unsigned* bar, volatile LAS unsigned* st) {
    XcdBarrier b; b.bar = bar; b.x = xb_xcc_id(); b.st = st;
    if (threadIdx.x == 0) (void)xb_add(&bar[XB_XCNT(b.x)], 1u);
    return b;
}
DI void xcd_barrier_complete(unsigned* bar, unsigned x, unsigned& nloc, unsigned& nx) {
    const unsigned G = gridDim.x * gridDim.y * gridDim.z;
    unsigned sum, cnt, mine, sp = 0u;
    for (;;) {
        sum = 0u; cnt = 0u; mine = 0u;
#pragma unroll
        for (unsigned j = 0; j < 16; ++j) { const unsigned c = xb_ld(&bar[XB_XCNT(j)]); sum += c; cnt += (c > 0u) ? 1u : 0u; mine = (j == x) ? c : mine; }
        if (sum == G) break;
        __builtin_amdgcn_s_sleep(1);
        if ((++sp & 255u) == 0u) { if (xb_ld(&bar[XB_TMO])) break; if (sp > XB_SPIN_CAP) { atomicAdd(&bar[XB_TMO], 1u); break; } }
    }
    nloc = mine > 0u ? mine : 1u; nx = cnt > 0u ? cnt : 1u;
}
DI void xcd_barrier(const XcdBarrier& b) {
    asm volatile("s_waitcnt vmcnt(0) lgkmcnt(0)" ::: "memory");
    __syncthreads();
    if (threadIdx.x == 0) {
        unsigned* bar = b.bar;
        __builtin_amdgcn_s_waitcnt(0);
        unsigned nloc = b.st[0], nx = b.st[1];
        if (nloc == 0u) { xcd_barrier_complete(bar, b.x, nloc, nx); b.st[0] = nloc; b.st[1] = nx; }
        const unsigned old = xb_add(&bar[XB_XSUB(b.x)], 1u);
        const unsigned gen = old / nloc;
        if (old + 1u == (gen + 1u) * nloc) {
            __builtin_amdgcn_fence(__ATOMIC_RELEASE, "agent");
            asm volatile("s_waitcnt vmcnt(0)" ::: "memory");
            const unsigned og = xb_add(&bar[XB_TOP], 1u);
            const unsigned tg = og / nx;
            if (og + 1u == (tg + 1u) * nx) xb_add(&bar[XB_TOPGEN], 1u);
            else XB_SPIN(xb_ld(&bar[XB_TOPGEN]) == tg, bar);
            __builtin_amdgcn_fence(__ATOMIC_ACQUIRE, "agent");
            xb_add(&bar[XB_XGEN(b.x)], 1u);
            asm volatile("s_waitcnt vmcnt(0)" ::: "memory");
        } else {
            XB_SPIN(xb_ld(&bar[XB_XGEN(b.x)]) == gen, bar);
            __builtin_amdgcn_fence(__ATOMIC_ACQUIRE, "agent");
            asm volatile("s_waitcnt vmcnt(0)" ::: "memory");
        }
    }
    __syncthreads();
}

constexpr int NPH = 13;
__global__ void __launch_bounds__(NTHREADS, 2) mega(Params P) {
    extern __shared__ __attribute__((aligned(16))) unsigned char lds[];
    cg::grid_group grid = cg::this_grid();
    const int tid = threadIdx.x, lane = tid & 63, wid = __builtin_amdgcn_readfirstlane(tid >> 6);
    const int gw = blockIdx.x * NWAVES + wid, ngw = gridDim.x * NWAVES;
#define gt ((size_t)blockIdx.x * NTHREADS + threadIdx.x)
#define ngt ((size_t)gridDim.x * NTHREADS)
    unsigned char* ws = P.ws;
    bf16_t* WIN = (bf16_t*)(ws + W_IN);
    bf16_t* XB = (bf16_t*)P.out;
    { volatile LAS unsigned* st_ = (volatile LAS unsigned*)((lptr)lds + 147456); if (tid == 0) { st_[0] = 0u; st_[1] = 0u; } }
    __syncthreads();
    const XcdBarrier xbar = xcd_barrier_post((unsigned*)(ws + O_BAR + 4096), (volatile LAS unsigned*)((lptr)lds + 147456));
#define PH_BEGIN(k) if (P.ph_lo <= (k) && (k) < P.ph_hi) {
#define PH_END(k) if ((k) + 1 < P.ph_hi) { if (P.ph_hi > 1000) grid.sync(); else xcd_barrier(xbar); } }
    PH_BEGIN(0) {
            cvt_rows(P.x, XB, (size_t)M * D / 8, gt, ngt);
            transpose_mat(P.w_in, 1024, 6864, WIN, NA, 1, gw, ngw, lane, lds);
        } PH_END(0)
    PH_BEGIN(1) { EpiProjA E{(bf16_t*)(ws + O_PROJA), (float*)(ws + O_AB)}; gemm_run(lds, XB, 1024, WIN, 1024, M, NA, 1024, E); } PH_END(1)
    PH_BEGIN(2) { p2_tokens(P, gw, ngw, lane);
            __syncthreads();
            transpose_rest(P, gw, ngw, lane, lds);
        } PH_END(2)
    PH_BEGIN(3) { delta_A(P, lds, gw, ngw, lane, wid);
                  __syncthreads();
                  { EpiQ E{(bf16_t*)(ws + O_Q)}; gemm_run(lds, (const bf16_t*)(ws + O_CQ), 384, (const bf16_t*)(ws + W_UQ), 384, M, 1536, 384, E); }
                  { EpiKV E{(bf16_t*)(ws + O_KN), (bf16_t*)(ws + O_V)}; gemm_run(lds, (const bf16_t*)(ws + O_CKV), 256, (const bf16_t*)(ws + W_UKV), 256, M, 2048, 256, E); } } PH_END(3)
    PH_BEGIN(4) {
        unsigned* ctl = (unsigned*)(ws + O_BAR);
        if (blockIdx.x < 32) { for (int u = blockIdx.x; u < 32; u += gridDim.x) delta_B2(P, lds, u);
            if (tid == 0) { asm volatile("s_waitcnt vmcnt(0)" ::: "memory"); __hip_atomic_fetch_add(ctl + 64 * 9, gridDim.x < 32 ? 32u / gridDim.x : 1u, __ATOMIC_RELEASE, __HIP_MEMORY_SCOPE_AGENT); } }
        attn_queue(P, lds, ctl + 64);
        if (tid == 0) { const unsigned want = gridDim.x < 32 ? (32u / gridDim.x) * gridDim.x : 32u; while (__hip_atomic_load(ctl + 64 * 9, __ATOMIC_RELAXED, __HIP_MEMORY_SCOPE_AGENT) < want) __builtin_amdgcn_s_sleep(2); }
        __syncthreads();
        {
            LAS int* slot = (LAS int*)((lptr)lds + 147392);
            for (;;) {
                __syncthreads();
                if (tid == 0) *slot = (int)__hip_atomic_fetch_add(ctl + 64 * 10, 1u, __ATOMIC_RELAXED, __HIP_MEMORY_SCOPE_AGENT);
                __syncthreads();
                const int c = *slot;
                if (c >= M * D / 16384) break;
                const float* s_ = P.x + (size_t)c * 16384 + tid * 8; bf16_t* d_ = XB + (size_t)c * 16384 + tid * 8;
                f32x4 va[4], vb[4];
#pragma unroll
                for (int j = 0; j < 4; ++j) { va[j] = *(const f32x4*)(s_ + j * 4096); vb[j] = *(const f32x4*)(s_ + j * 4096 + 4); }
#pragma unroll
                for (int j = 0; j < 4; ++j) { u32x4 o; o.x = pk2(va[j][0], va[j][1]); o.y = pk2(va[j][2], va[j][3]); o.z = pk2(vb[j][0], vb[j][1]); o.w = pk2(vb[j][2], vb[j][3]); *(u32x4*)(d_ + j * 4096) = o; }
            }
        }
    } PH_END(4)
    PH_BEGIN(5) { EpiZG E{(bf16_t*)(ws + O_Z), (bf16_t*)(ws + O_GD), (bf16_t*)(ws + O_GM)}; gemm_run(lds, XB, 1024, WIN + (size_t)NA * 1024, 1024, M, NB, 1024, E); } PH_END(5)
    PH_BEGIN(6) p9_normgate(P, lds, gw, ngw, lane, wid); PH_END(6)
    PH_BEGIN(7) { { EpiYdn E{(bf16_t*)(ws + O_GD)}; gemm_run(lds, (const bf16_t*)P.out + (size_t)M * 1024, 1024, (const bf16_t*)(ws + W_BRDN), 1024, M, 1024, 1024, E); }
                  asm volatile("s_waitcnt vmcnt(0)" ::: "memory");
                  { EpiYmla E{(const bf16_t*)(ws + O_GD), (bf16_t*)(ws + O_GM)}; gemm_run(lds, (const bf16_t*)(ws + O_Q), 1536, (const bf16_t*)(ws + W_BRMLA), 1536, M, 1024, 1536, E); } } PH_END(7)
    PH_BEGIN(8) { EpiWo E{P.x, P.out}; gemm_run(lds, (const bf16_t*)(ws + O_GM), 1024, (const bf16_t*)(ws + W_O), 1024, M, 1024, 1024, E); } PH_END(8)
    PH_BEGIN(9) { ln_rows(P.out, (float*)(ws + O_H1), (bf16_t*)(ws + O_H1B), P.ln1_g, P.ln1_b, gw, ngw, lane);
                  cvt_rows(P.p, (bf16_t*)(ws + O_PB), (size_t)M * 256 / 8, gt, ngt); } PH_END(9)
    PH_BEGIN(10) { { EpiFfnIn E{(bf16_t*)(ws + O_ACT)}; gemm_run(lds, (const bf16_t*)(ws + O_H1B), 1024, (const bf16_t*)(ws + W_FFNIN), 1024, M, 5632, 1024, E); }
                   { EpiSg E{(bf16_t*)P.out}; gemm_run(lds, (const bf16_t*)(ws + O_H1B), 1024, (const bf16_t*)(ws + W_PG), 1024, M, 1024, 1024, E); }
                   { EpiStore E{(bf16_t*)P.out + (size_t)M * 1024, 1024}; gemm_run(lds, (const bf16_t*)(ws + O_PB), 256, (const bf16_t*)(ws + W_PLE), 256, M, 1024, 256, E); } } PH_END(10)
    PH_BEGIN(11) { EpiFfnOut E{(float*)(ws + O_H1), (const bf16_t*)P.out, (const bf16_t*)P.out + (size_t)M * 1024}; gemm_run(lds, (const bf16_t*)(ws + O_ACT), FF, (const bf16_t*)(ws + W_FFNOUT), FF, M, 1024, FF, E); } PH_END(11)
    PH_BEGIN(12) ln_rows((const float*)(ws + O_H1), P.out, nullptr, P.ln2_g, P.ln2_b, gw, ngw, lane); PH_END(12)
}

extern "C" void kernel_launch(void* const* d_in, const int* in_sizes, int n_in, void* d_out, int out_size, void* d_ws, size_t ws_size, hipStream_t stream) {
    static int grid = 0;
    if (grid == 0) {
        int dev = 0, cus = 0, per_cu = 0;
        (void)hipGetDevice(&dev);
        (void)hipDeviceGetAttribute(&cus, hipDeviceAttributeMultiprocessorCount, dev);
        (void)hipFuncSetAttribute((const void*)mega, hipFuncAttributeMaxDynamicSharedMemorySize, LDS_BYTES);
        (void)hipOccupancyMaxActiveBlocksPerMultiprocessor(&per_cu, (const void*)mega, NTHREADS, LDS_BYTES);
        if (per_cu < 1) per_cu = 1;
        grid = cus * per_cu;
        if (ws_size < 256 * MiB) { fprintf(stderr, "workspace too small: %zu\n", ws_size); grid = -1; }
    }
    if (grid < 0) return;
    (void)hipMemsetAsync((unsigned char*)d_ws + O_BAR, 0, 4096 + 16384, stream);
    Params P{};
    const float** pf = (const float**)&P;
    for (int i = 0; i < 24; ++i) pf[i] = (const float*)d_in[i];
    P.out = (float*)d_out; P.ws = (unsigned char*)d_ws;
#if NLAUNCH == 1
    P.ph_lo = 0; P.ph_hi = NPH;
    { void* args[] = {&P}; hipError_t e = hipLaunchCooperativeKernel((const void*)mega, dim3(grid), dim3(NTHREADS), args, LDS_BYTES, stream);
      if (e != hipSuccess) fprintf(stderr, "cooperative launch failed: %s\n", hipGetErrorString(e)); }
#else
    for (int ph = 0; ph < NPH; ++ph) { P.ph_lo = ph; P.ph_hi = ph + 1; void* args[] = {&P};
        hipError_t e = hipLaunchCooperativeKernel((const void*)mega, dim3(grid), dim3(NTHREADS), args, LDS_BYTES, stream);
        if (e != hipSuccess) { fprintf(stderr, "cooperative launch failed: %s\n", hipGetErrorString(e)); break; } }
#endif
}
```
